# Optimizing an MI355X kernel written in HIP

```python
import math
import jax
import jax.numpy as jnp
from jax import lax
import numpy as np

D_MODEL = 4096
BATCH = 4
SEQ = 2048
DEPTH = 1
DEC_BATCH = 32
DEC_SEQ = 1
PAST_LEN = 8192
PAGE_SIZE = 128

HEAD_DIM = 128
LRU_WIDTH = 1536
LRU_BLOCKS = 12
LRU_BLOCK = LRU_WIDTH // LRU_BLOCKS
CONV_WIDTH = 4
LRU_C = 8.0
DIL_PAIRS = ((128, 1), (512, 4), (2048, 16))
N_GROUPS = len(DIL_PAIRS)
HPG = 4
DIL_HEADS = N_GROUPS * HPG
DIL_WIDTH = DIL_HEADS * HEAD_DIM
DIL_OUT = HPG * HEAD_DIM
BAND = 128
DIL_SCALE = HEAD_DIM ** -0.5
N_BUCKETS = 32
MAX_DISTANCE = 2048
MEM_TOKENS = 256
MEM_HEADS = 4
MEM_HEAD_DIM = 256
MEM_WIDTH = MEM_HEADS * MEM_HEAD_DIM
MEM_SCALE = MEM_HEAD_DIM ** -0.5
N_BRANCH = 3
PEER_HEADS = 8
PEER_NKEYS = 128
PEER_N = PEER_NKEYS * PEER_NKEYS
PEER_DQ = 256
PEER_TOPK = 16
PEER_BLOCK = 128
EPS = 1e-6

O_LRU_X = 0
O_LRU_G = O_LRU_X + LRU_WIDTH
O_Q = O_LRU_G + LRU_WIDTH
O_K = O_Q + DIL_WIDTH
O_V = O_K + DIL_WIDTH
O_MQ = O_V + DIL_WIDTH
O_GATE = O_MQ + MEM_WIDTH
IN_COLS = O_GATE + N_BRANCH * D_MODEL

kernel_name = 'hawk_dilated_peer_hybrid_step'


def rmsnorm(x, g):
    xf = x.astype(jnp.float32)
    y = xf * lax.rsqrt(jnp.mean(xf * xf, axis=-1, keepdims=True) + EPS)
    return (y * g.astype(jnp.float32)).astype(x.dtype)


def t5_bucket(dist):
    max_exact = N_BUCKETS // 2
    d = jnp.maximum(dist, 1).astype(jnp.float32)
    large = max_exact + (jnp.log(d / max_exact) / math.log(MAX_DISTANCE / max_exact)
                         * (N_BUCKETS - max_exact)).astype(jnp.int32)
    large = jnp.minimum(large, N_BUCKETS - 1)
    return jnp.where(dist < max_exact, dist, large)


def group_bias(rel_bias, g):
    dil = DIL_PAIRS[g][1]
    dist = jnp.arange(BAND + 1, dtype=jnp.int32) * dil
    return rel_bias[t5_bucket(dist)][:, g * HPG:(g + 1) * HPG].astype(jnp.float32)


def rglru(x_in, gate_in, conv_state, h0, lp):
    B, T, _ = x_in.shape
    xp = jnp.concatenate([conv_state.astype(x_in.dtype), x_in], axis=1)
    xc = lp['conv_b'] + xp[:, 0:T] * lp['conv_w'][0]
    for k in range(1, CONV_WIDTH):
        xc = xc + xp[:, k:k + T] * lp['conv_w'][k]
    xb = xc.reshape(B, T, LRU_BLOCKS, LRU_BLOCK)
    r = jax.nn.sigmoid(jnp.einsum('btni,nio->btno', xb, lp['lru_wa']) + lp['lru_ba']).reshape(B, T, LRU_WIDTH)
    i = jax.nn.sigmoid(jnp.einsum('btni,nio->btno', xb, lp['lru_wi']) + lp['lru_bi']).reshape(B, T, LRU_WIDTH)
    log_a = -LRU_C * r.astype(jnp.float32) * jax.nn.softplus(-lp['lru_lambda'].astype(jnp.float32))
    a = jnp.exp(log_a)
    b = jnp.sqrt(-jnp.expm1(2.0 * log_a)) * (i * xc).astype(jnp.float32)
    b = b.at[:, 0].add(a[:, 0] * h0.astype(jnp.float32))

    def combine(lhs, rhs):
        a_l, b_l = lhs
        a_r, b_r = rhs
        return a_l * a_r, a_r * b_l + b_r

    _, h = lax.associative_scan(combine, (a, b), axis=1)
    y = h.astype(x_in.dtype) * jax.nn.gelu(gate_in)
    return y, xp[:, T:], h[:, -1].astype(x_in.dtype)


def dil_qkv(z, lp):
    B, T, _ = z.shape
    q = rmsnorm(z[..., O_Q:O_K].reshape(B, T, DIL_HEADS, HEAD_DIM), lp['dil_qn_g'])
    k = rmsnorm(z[..., O_K:O_V].reshape(B, T, DIL_HEADS, HEAD_DIM), lp['dil_kn_g'])
    v = z[..., O_V:O_MQ].reshape(B, T, DIL_HEADS, HEAD_DIM)
    return q, k, v


def dilated_prompt(q, k, v, bias_j, dil):
    B, S, H, Dh = q.shape
    L = S // dil
    nb = -(-L // BAND)
    Lp = nb * BAND

    def to_blocks(t):
        t = t.reshape(B, L, dil, H, Dh).transpose(0, 2, 1, 3, 4)
        t = jnp.pad(t, ((0, 0), (0, 0), (0, Lp - L), (0, 0), (0, 0)))
        return t.reshape(B, dil, nb, BAND, H, Dh)

    def with_prev(t):
        prev = jnp.pad(t[:, :, :-1], ((0, 0), (0, 0), (1, 0), (0, 0), (0, 0), (0, 0)))
        return jnp.concatenate([prev, t], axis=3)

    qb = to_blocks(q)
    kb = with_prev(to_blocks(k))
    vb = with_prev(to_blocks(v))
    qi = jnp.arange(BAND)[:, None]
    ki = jnp.arange(2 * BAND)[None, :]
    off = qi + BAND - ki
    key_pos = (jnp.arange(nb)[:, None] - 1) * BAND + jnp.arange(2 * BAND)[None, :]
    mask = ((off >= 0) & (off <= BAND))[None] & (key_pos >= 0)[:, None, :]
    bias = bias_j[jnp.clip(off, 0, BAND)].transpose(2, 0, 1)
    s = jnp.einsum('brnqhd,brnkhd->brnhqk', qb, kb).astype(jnp.float32) * DIL_SCALE + bias
    s = jnp.where(mask[:, None], s, -jnp.inf)
    m = jnp.max(s, axis=-1, keepdims=True)
    p = jnp.exp(s - m)
    denom = jnp.sum(p, axis=-1)
    o = jnp.einsum('brnhqk,brnkhd->brnqhd', p.astype(v.dtype), vb).astype(jnp.float32)
    o = o / jnp.moveaxis(denom, 3, 4)[..., None]
    lse = jnp.moveaxis(m[..., 0] + jnp.log(denom), 3, 4)
    o = o.reshape(B, dil, Lp, H, Dh)[:, :, :L].transpose(0, 2, 1, 3, 4).reshape(B, S, H, Dh)
    lse = lse.reshape(B, dil, Lp, H)[:, :, :L].transpose(0, 2, 1, 3).reshape(B, S, H)
    return o, lse


def dilated_sample(q, k_new, v_new, buf, bias_j, dil):
    T = q.shape[1]
    Wb = buf.shape[1]
    kk = jnp.concatenate([buf[:, :, 0].astype(k_new.dtype), k_new], axis=1)
    vv = jnp.concatenate([buf[:, :, 1].astype(v_new.dtype), v_new], axis=1)
    idx = Wb + jnp.arange(T)[:, None] - jnp.arange(BAND + 1)[None, :] * dil
    valid = idx >= 0
    idx = jnp.maximum(idx, 0)
    kg = kk[:, idx]
    vg = vv[:, idx]
    s = jnp.einsum('bthd,btjhd->bthj', q, kg).astype(jnp.float32) * DIL_SCALE + bias_j.T
    s = jnp.where(valid[None, :, None, :], s, -jnp.inf)
    m = jnp.max(s, axis=-1, keepdims=True)
    p = jnp.exp(s - m)
    denom = jnp.sum(p, axis=-1)
    o = jnp.einsum('bthj,btjhd->bthd', p.astype(vv.dtype), vg).astype(jnp.float32) / denom[..., None]
    lse = m[..., 0] + jnp.log(denom)
    new_buf = jnp.stack([kk, vv], axis=2)[:, T:]
    return o, lse, new_buf


def combine_groups(outs, lses, dtype):
    w = jax.nn.softmax(jnp.stack(lses, axis=0), axis=0)
    o = jnp.einsum('gbth,gbthd->bthd', w, jnp.stack(outs, axis=0))
    B, T = o.shape[:2]
    return o.reshape(B, T, DIL_OUT).astype(dtype)


def mem_kv(mem, lp):
    B, M, _ = mem.shape
    kv = (rmsnorm(mem, lp['mem_norm_g']) @ lp['w_mem_kv']).reshape(B, M, 2, MEM_HEADS, MEM_HEAD_DIM)
    k = rmsnorm(kv[:, :, 0], lp['mem_kn_g'])
    return jnp.stack([k, kv[:, :, 1]], axis=2)


def mem_attend(z, kv, lp):
    B, T, _ = z.shape
    q = rmsnorm(z[..., O_MQ:O_GATE].reshape(B, T, MEM_HEADS, MEM_HEAD_DIM), lp['mem_qn_g'])
    s = jnp.einsum('bthd,bmhd->bhtm', q, kv[:, :, 0]).astype(jnp.float32) * MEM_SCALE
    p = jax.nn.softmax(s, axis=-1)
    o = jnp.einsum('bhtm,bmhd->bthd', p.astype(kv.dtype), kv[:, :, 1])
    return o.reshape(B, T, MEM_WIDTH)


def merge_out(x, z, y_a, y_b, y_m, lp):
    B, T, _ = x.shape
    g = jax.nn.sigmoid(z[..., O_GATE:].reshape(B, T, N_BRANCH, D_MODEL))
    merged = (g[:, :, 0] * (y_a @ lp['w_br_a'])
              + g[:, :, 1] * (y_b @ lp['w_br_b'])
              + g[:, :, 2] * (y_m @ lp['w_br_m']))
    return x + merged @ lp['w_out']


def peer(x, lp):
    shp = x.shape
    h = rmsnorm(x, lp['norm2_g']).reshape(-1, D_MODEL)
    n = h.shape[0]
    nb = -(-n // PEER_BLOCK)
    h = jnp.pad(h, ((0, nb * PEER_BLOCK - n), (0, 0))).reshape(nb, PEER_BLOCK, D_MODEL)

    def block(xb):
        q = (xb @ lp['peer_wq']).reshape(PEER_BLOCK, PEER_HEADS, 2, PEER_DQ // 2)
        s = jnp.einsum('thpk,hpnk->thpn', q, lp['peer_subkeys']).astype(jnp.float32)
        s1, i1 = lax.top_k(s[:, :, 0], PEER_TOPK)
        s2, i2 = lax.top_k(s[:, :, 1], PEER_TOPK)
        cand = (s1[..., :, None] + s2[..., None, :]).reshape(PEER_BLOCK, PEER_HEADS, PEER_TOPK * PEER_TOPK)
        cand_id = (i1[..., :, None] * PEER_NKEYS + i2[..., None, :]).reshape(PEER_BLOCK, PEER_HEADS, PEER_TOPK * PEER_TOPK)
        st, pos = lax.top_k(cand, PEER_TOPK)
        ids = jnp.take_along_axis(cand_id, pos, axis=-1)
        g = jax.nn.softmax(st, axis=-1)
        act = jax.nn.gelu(jnp.einsum('td,thkd->thk', xb, lp['peer_u'][ids]).astype(jnp.float32))
        return jnp.einsum('thk,thkd->td', (g * act).astype(xb.dtype), lp['peer_v'][ids])

    out = lax.map(block, h).reshape(-1, D_MODEL)[:n].reshape(shp)
    return x + out


def layer_prompt(x, mem, rel_bias, lp):
    B, T, _ = x.shape
    z = rmsnorm(x, lp['norm1_g']) @ lp['w_in']
    y_a, conv_new, h_new = rglru(z[..., O_LRU_X:O_LRU_G], z[..., O_LRU_G:O_Q],
                                 jnp.zeros((B, CONV_WIDTH - 1, LRU_WIDTH), x.dtype),
                                 jnp.zeros((B, LRU_WIDTH), x.dtype), lp)
    q, k, v = dil_qkv(z, lp)
    outs, lses, bufs = [], [], []
    for g in range(N_GROUPS):
        w, d = DIL_PAIRS[g]
        hs = slice(g * HPG, (g + 1) * HPG)
        o, lse = dilated_prompt(q[:, :, hs], k[:, :, hs], v[:, :, hs], group_bias(rel_bias, g), d)
        outs.append(o)
        lses.append(lse)
        bufs.append(jnp.stack([k[:, :, hs], v[:, :, hs]], axis=2)[:, T - min(w, T):])
    y_b = combine_groups(outs, lses, x.dtype)
    mkv = mem_kv(mem, lp)
    y_m = mem_attend(z, mkv, lp)
    x = merge_out(x, z, y_a, y_b, y_m, lp)
    x = peer(x, lp)
    return x, conv_new, h_new, bufs, mkv


def layer_sample(x, conv_state, h0, bufs, mem_cache, rel_bias, lp):
    z = rmsnorm(x, lp['norm1_g']) @ lp['w_in']
    y_a, conv_new, h_new = rglru(z[..., O_LRU_X:O_LRU_G], z[..., O_LRU_G:O_Q], conv_state, h0, lp)
    q, k, v = dil_qkv(z, lp)
    outs, lses, new_bufs = [], [], []
    for g in range(N_GROUPS):
        hs = slice(g * HPG, (g + 1) * HPG)
        o, lse, nbuf = dilated_sample(q[:, :, hs], k[:, :, hs], v[:, :, hs], bufs[g],
                                      group_bias(rel_bias, g), DIL_PAIRS[g][1])
        outs.append(o)
        lses.append(lse)
        new_bufs.append(nbuf)
    y_b = combine_groups(outs, lses, x.dtype)
    y_m = mem_attend(z, mem_cache.astype(x.dtype), lp)
    x = merge_out(x, z, y_a, y_b, y_m, lp)
    x = peer(x, lp)
    return x, conv_new, h_new, new_bufs


def setup_inputs(seed: int = 0) -> dict:
    key = jax.random.key(seed)
    ks = jax.random.split(key, 40)

    def nrm(i, shape, scale):
        return jax.random.normal(ks[i], shape, jnp.float32) * scale

    a0 = jax.random.uniform(ks[39], (DEPTH, LRU_WIDTH), jnp.float32, 0.9, 0.999)
    root = a0 ** (1.0 / LRU_C)
    lam = jnp.log(root) - jnp.log1p(-root)
    win = [min(w, PAST_LEN) for w, _ in DIL_PAIRS]
    return {
        'x_prompt': nrm(0, (BATCH, SEQ, D_MODEL), 1.0),
        'x_sample': nrm(1, (DEC_BATCH, DEC_SEQ, D_MODEL), 1.0),
        'state_conv': nrm(2, (DEPTH, DEC_BATCH, CONV_WIDTH - 1, LRU_WIDTH), 0.5),
        'state_rnn': nrm(3, (DEPTH, DEC_BATCH, LRU_WIDTH), 0.5),
        'cache_swa0': nrm(4, (DEPTH, DEC_BATCH, win[0], 2, HPG, HEAD_DIM), 1.0),
        'cache_swa1': nrm(5, (DEPTH, DEC_BATCH, win[1], 2, HPG, HEAD_DIM), 1.0),
        'cache_swa2': nrm(6, (DEPTH, DEC_BATCH, win[2], 2, HPG, HEAD_DIM), 1.0),
        'cache_mem': nrm(7, (DEPTH, DEC_BATCH, MEM_TOKENS, 2, MEM_HEADS, MEM_HEAD_DIM), 1.0),
        'mem_prompt': nrm(8, (BATCH, MEM_TOKENS, D_MODEL), 1.0),
        'rel_bias': nrm(9, (N_BUCKETS, DIL_HEADS), 0.5),
        'norm1_g': 1.0 + nrm(10, (DEPTH, D_MODEL), 0.05),
        'w_in': nrm(11, (DEPTH, D_MODEL, IN_COLS), D_MODEL ** -0.5),
        'conv_w': nrm(12, (DEPTH, CONV_WIDTH, LRU_WIDTH), 0.5),
        'conv_b': nrm(13, (DEPTH, LRU_WIDTH), 0.02),
        'lru_wa': nrm(14, (DEPTH, LRU_BLOCKS, LRU_BLOCK, LRU_BLOCK), LRU_BLOCK ** -0.5),
        'lru_ba': nrm(15, (DEPTH, LRU_BLOCKS, LRU_BLOCK), 0.02),
        'lru_wi': nrm(16, (DEPTH, LRU_BLOCKS, LRU_BLOCK, LRU_BLOCK), LRU_BLOCK ** -0.5),
        'lru_bi': nrm(17, (DEPTH, LRU_BLOCKS, LRU_BLOCK), 0.02),
        'lru_lambda': lam,
        'dil_qn_g': 1.0 + nrm(18, (DEPTH, HEAD_DIM), 0.05),
        'dil_kn_g': 1.0 + nrm(19, (DEPTH, HEAD_DIM), 0.05),
        'mem_norm_g': 1.0 + nrm(20, (DEPTH, D_MODEL), 0.05),
        'w_mem_kv': nrm(21, (DEPTH, D_MODEL, 2 * MEM_WIDTH), D_MODEL ** -0.5),
        'mem_qn_g': 1.0 + nrm(22, (DEPTH, MEM_HEAD_DIM), 0.05),
        'mem_kn_g': 1.0 + nrm(23, (DEPTH, MEM_HEAD_DIM), 0.05),
        'w_br_a': nrm(24, (DEPTH, LRU_WIDTH, D_MODEL), LRU_WIDTH ** -0.5),
        'w_br_b': nrm(25, (DEPTH, DIL_OUT, D_MODEL), DIL_OUT ** -0.5),
        'w_br_m': nrm(26, (DEPTH, MEM_WIDTH, D_MODEL), MEM_WIDTH ** -0.5),
        'w_out': nrm(27, (DEPTH, D_MODEL, D_MODEL), D_MODEL ** -0.5),
        'norm2_g': 1.0 + nrm(28, (DEPTH, D_MODEL), 0.05),
        'peer_wq': nrm(29, (DEPTH, D_MODEL, PEER_HEADS * PEER_DQ), D_MODEL ** -0.5),
        'peer_subkeys': nrm(30, (DEPTH, PEER_HEADS, 2, PEER_NKEYS, PEER_DQ // 2), (PEER_DQ // 2) ** -0.5),
        'peer_u': nrm(31, (DEPTH, PEER_N, D_MODEL), D_MODEL ** -0.5),
        'peer_v': nrm(32, (DEPTH, PEER_N, D_MODEL), 0.1),
    }


def reference(x_prompt, x_sample, state_conv, state_rnn, cache_swa0, cache_swa1, cache_swa2, cache_mem,
              mem_prompt, rel_bias, norm1_g, w_in, conv_w, conv_b, lru_wa, lru_ba, lru_wi, lru_bi,
              lru_lambda, dil_qn_g, dil_kn_g, mem_norm_g, w_mem_kv, mem_qn_g, mem_kn_g, w_br_a, w_br_b,
              w_br_m, w_out, norm2_g, peer_wq, peer_subkeys, peer_u, peer_v):
    xp = x_prompt
    xs = x_sample
    pc, pr, p0, p1, p2, pm = [], [], [], [], [], []
    sc, sr, s0, s1, s2 = [], [], [], [], []
    for l in range(DEPTH):
        lp = {
            'norm1_g': norm1_g[l], 'w_in': w_in[l], 'conv_w': conv_w[l], 'conv_b': conv_b[l],
            'lru_wa': lru_wa[l], 'lru_ba': lru_ba[l], 'lru_wi': lru_wi[l], 'lru_bi': lru_bi[l],
            'lru_lambda': lru_lambda[l], 'dil_qn_g': dil_qn_g[l], 'dil_kn_g': dil_kn_g[l],
            'mem_norm_g': mem_norm_g[l], 'w_mem_kv': w_mem_kv[l], 'mem_qn_g': mem_qn_g[l],
            'mem_kn_g': mem_kn_g[l], 'w_br_a': w_br_a[l], 'w_br_b': w_br_b[l], 'w_br_m': w_br_m[l],
            'w_out': w_out[l], 'norm2_g': norm2_g[l], 'peer_wq': peer_wq[l],
            'peer_subkeys': peer_subkeys[l], 'peer_u': peer_u[l], 'peer_v': peer_v[l],
        }
        xp, c_p, h_p, bufs_p, mkv_p = layer_prompt(xp, mem_prompt, rel_bias, lp)
        xs, c_s, h_s, bufs_s = layer_sample(xs, state_conv[l], state_rnn[l],
                                            (cache_swa0[l], cache_swa1[l], cache_swa2[l]),
                                            cache_mem[l], rel_bias, lp)
        pc.append(c_p)
        pr.append(h_p)
        p0.append(bufs_p[0])
        p1.append(bufs_p[1])
        p2.append(bufs_p[2])
        pm.append(mkv_p)
        sc.append(c_s)
        sr.append(h_s)
        s0.append(bufs_s[0])
        s1.append(bufs_s[1])
        s2.append(bufs_s[2])
    p_conv = jnp.stack(pc)
    p_rnn = jnp.stack(pr)
    p_swa0 = jnp.stack(p0)
    p_swa1 = jnp.stack(p1)
    p_swa2 = jnp.stack(p2)
    p_mem = jnp.stack(pm)
    s_conv = jnp.stack(sc)
    s_rnn = jnp.stack(sr)
    s_swa0 = jnp.stack(s0)
    s_swa1 = jnp.stack(s1)
    s_swa2 = jnp.stack(s2)
    return (xp, xs, p_conv, p_rnn, p_swa0, p_swa1, p_swa2, p_mem, s_conv, s_rnn, s_swa0, s_swa1, s_swa2)
```

```cpp
#include <hip/hip_runtime.h>
#include <cstdio>
#include <cstdint>

#define GAS __attribute__((address_space(1)))
#define LAS __attribute__((address_space(3)))
typedef unsigned short bf16;
typedef short bf16x8 __attribute__((ext_vector_type(8)));
typedef float f32x4 __attribute__((ext_vector_type(4)));
typedef float f32x2 __attribute__((ext_vector_type(2)));
typedef unsigned u32x4 __attribute__((ext_vector_type(4)));
typedef unsigned u32x2 __attribute__((ext_vector_type(2)));

constexpr int DM = 4096, NBATCH = 4, SEQ = 2048, MP = NBATCH * SEQ, MS = 32, MREAL = MP + MS, MALL = 8448;
constexpr int LRUW = 1536, NLB = 12, HD = 128, NDH = 12, DILW = NDH * HD, MEMT = 256, MEMH = 4, MEMD = 256, MEMW = 1024;
constexpr int O_LX = 0, O_LG = 1536, O_Q = 3072, O_K = 4608, O_V = 6144, O_MQ = 7680, O_GATE = 8704, INC = 20992;
constexpr int KCAT = 3072;
constexpr int PH = 8, PNK = 128, PTOP = 16, PNE = 16384, PQW = 2048;
constexpr float EPS = 1e-6f;

__device__ __forceinline__ float bf2f(unsigned v) { return __uint_as_float(v << 16); }
__device__ __forceinline__ float bflo(unsigned w) { return __uint_as_float(w << 16); }
__device__ __forceinline__ float bfhi(unsigned w) { return __uint_as_float(w & 0xffff0000u); }
__device__ __forceinline__ unsigned cvt_pk_bf16(float lo, float hi) { unsigned r; asm volatile("v_cvt_pk_bf16_f32 %0, %1, %2" : "=v"(r) : "v"(lo), "v"(hi)); return r; }
__device__ __forceinline__ float wave_sum(float v) {
#pragma unroll
    for (int o = 1; o < 64; o <<= 1) v += __shfl_xor(v, o);
    return v;
}
__device__ __forceinline__ float wave_max(float v) {
#pragma unroll
    for (int o = 1; o < 64; o <<= 1) v = fmaxf(v, __shfl_xor(v, o));
    return v;
}
__device__ __forceinline__ float fast_exp(float x) { return __builtin_amdgcn_exp2f(x * 1.44269504089f); }
__device__ __forceinline__ float sigmoidf_(float x) { return __builtin_amdgcn_rcpf(1.0f + fast_exp(-x)); }
__device__ __forceinline__ float gelu_tanh(float x) { const float u = 0.7978845608f * (x + 0.044715f * x * x * x); return x * sigmoidf_(2.0f * u); }
__device__ __forceinline__ int launder(int x) { asm volatile("" : "+v"(x)); return x; }
__device__ __forceinline__ int lane_id() { return (int)__builtin_amdgcn_mbcnt_hi(~0u, __builtin_amdgcn_mbcnt_lo(~0u, 0u)); }
#define LDS_WAIT() asm volatile("s_waitcnt lgkmcnt(0)" ::: "memory")
#define VM_WAIT() asm volatile("s_waitcnt vmcnt(0)" ::: "memory")

namespace pg8 {
#define PG8_LAS __attribute__((address_space(3)))
typedef unsigned short bf16_t;
typedef short bf16x8 __attribute__((ext_vector_type(8)));
typedef float f32x4 __attribute__((ext_vector_type(4)));
typedef unsigned u32x4 __attribute__((ext_vector_type(4)));
typedef int i32x4 __attribute__((ext_vector_type(4)));
constexpr int BM = 256, BK = 64, HALF = 128, HTB = HALF * BK * 2  , STAGE_BYTES = 8 * HTB, NXCD = 8, WGM = 8;

__host__ __device__ __forceinline__ int lds_byte(int r, int c) { const int st = (r >> 4) * 2 + (c >> 5), rr = r & 15, cc = c & 31, ob = rr * 64 + cc * 2; return st * 1024 + (ob ^ (((ob >> 9) & 1) << 5)); }
__host__ __device__ __forceinline__ void stage_rc(int b, int& R, int& C) { const int st = b / 1024, sb = b % 1024, swz = sb ^ (((sb >> 9) & 1) << 5); R = (st >> 1) * 16 + swz / 64; C = (st & 1) * 32 + (swz % 64) / 2; }
__host__ __device__ __forceinline__ int perm32(int rho) { const int n = rho >> 4, i = rho & 15; return 8 * (i >> 2) + 4 * n + (i & 3); }

struct Unit { int pm, pn; };
struct Gemm { const bf16_t* A; const bf16_t* Bt; int M, N, K; };

struct StaticOrder {
    int nM, nN, nwg, G, c;
    __host__ __device__ void init(int M, int N, int G_, int c_) { nM = M / BM; nN = N / BM; nwg = nM * nN; G = G_; c = c_; }
    __host__ __device__ bool next(int i, Unit& u) const {
        const long L = (long)i * G + c; if (L >= nwg) return false;
        int wgid = (int)L; { const int q = nwg / NXCD, r = nwg % NXCD, xcd = wgid % NXCD, off = wgid / NXCD; wgid = (xcd < r ? xcd * (q + 1) : r * (q + 1) + (xcd - r) * q) + off; }
        const int nig = WGM * nN, gid = wgid / nig, fm = gid * WGM, gsz = (nM - fm) < WGM ? (nM - fm) : WGM;
        u.pm = fm + ((wgid % nig) % gsz); u.pn = (wgid % nig) / gsz; return true;
    }
    __device__ __forceinline__ void a_ready(const Unit&) const {}
    __device__ __forceinline__ void done(const Unit&) const {}
};


struct SchedZ8 : StaticOrder {
    __host__ __device__ bool next(int i, Unit& u) const {
        long L;
        if (G == 256) { if (i < 9) L = (long)i * 256 + c; else { if (c >= 96 || i > 10) return false; L = 2304 + (i - 9) * 96 + c; } }
        else L = (long)i * G + c;
        if (L < 2048) { StaticOrder::next(i, u); u.pn = u.pn < 12 ? u.pn + 6 : u.pn + 18; return true; }
        int e = (int)(L - 2048); if (e >= 448) return false;
        if (e >= 376) { e -= 376; if (e < 64) { u.pn = 22 + (e >> 5); u.pm = e & 31; } else { u.pn = 28; u.pm = e - 64; } return true; }
        if (e < 168) { const int pp = e % 28; u.pn = e / 28; u.pm = (pp / 7) * 8 + pp % 7; return true; } e -= 168;
        if (e < 112) { const int t = e / 28, pp = e % 28; u.pn = (t < 2 ? 18 + t : 22 + t); u.pm = (pp / 7) * 8 + pp % 7; return true; } e -= 112;
        { const int t = e / 24, pp = e % 24; u.pn = (t < 2 ? 20 + t : 24 + t); u.pm = (pp / 6) * 8 + pp % 6; return true; }
    }
};
struct SchedZB : StaticOrder {
    __host__ __device__ bool next(int i, Unit& u) const {
        const long L = (long)i * G + c; if (L >= 128) return false;
        int e = (int)L;
        if (e < 56) { if (e < 24) { u.pn = 28 - 12; u.pm = 8 + e; } else { u.pn = 29 - 12; u.pm = e - 24; } return true; } e -= 56;
        if (e < 32) { const int t = e >> 3, pp = e & 7; u.pn = (t < 2 ? 20 + t : 24 + t) - 12; u.pm = (pp >> 1) * 8 + 6 + (pp & 1); return true; } e -= 32;
        if (e < 16) { const int t = e >> 2; u.pn = (t < 2 ? 18 + t : 22 + t) - 12; u.pm = (e & 3) * 8 + 7; return true; } e -= 16;
        { u.pn = e >> 2; u.pm = (e & 3) * 8 + 7; return true; }
    }
};
__device__ __forceinline__ unsigned pk_bf16(float lo, float hi) { unsigned r; asm volatile("v_cvt_pk_bf16_f32 %0, %1, %2" : "=v"(r) : "v"(lo), "v"(hi)); return r; }
__device__ __forceinline__ float sigm(float x) { return __builtin_amdgcn_rcpf(1.0f + __builtin_amdgcn_exp2f(x * -1.44269504089f)); }

struct EpiZ {
    static constexpr bool PERM = true, AFTER_DRAIN = false, HOOK = false, I8 = false; typedef f32x4 acc_t;
    bf16_t* O; int ldc;
    __device__ __forceinline__ void hook(f32x4 (&)[2][2][4][2], const Unit&, int, int, int, int, int) const {}
    __device__ __forceinline__ void operator()(f32x4 (&acc)[2][2][4][2], const Unit& u, int wr, int wc, int fr, int fq) const {
        { asm volatile("" : "+v"(fr), "+v"(fq)); } const int pno = u.pn < 6 ? u.pn : u.pn + 12; const int row0 = u.pm * BM + wr * 64 + fr, col0 = pno * BM + wc * 32 + 8 * fq;
#pragma unroll
        for (int ai = 0; ai < 2; ++ai)
#pragma unroll
            for (int m = 0; m < 4; ++m) { bf16_t* rowp = O + (size_t)(row0 + ai * HALF + m * 16) * ldc + col0;
#pragma unroll
                for (int bj = 0; bj < 2; ++bj) { const f32x4 v0 = acc[ai][bj][m][0], v1 = acc[ai][bj][m][1];
                    u32x4 w; w.x = pk_bf16(v0[0], v0[1]); w.y = pk_bf16(v0[2], v0[3]); w.z = pk_bf16(v1[0], v1[1]); w.w = pk_bf16(v1[2], v1[3]);
                    *(u32x4*)(rowp + bj * HALF) = w; } }
    }
};
template <bool ZMAP> struct EpiQ8 {
    static constexpr bool PERM = true, AFTER_DRAIN = false, HOOK = false, I8 = true; typedef i32x4 acc_t;
    bf16_t* O; int ldc; const float* SA; const float* SW; unsigned char* G8;
    __device__ __forceinline__ void hook(i32x4 (&)[2][2][4][2], const Unit&, int, int, int, int, int) const {}
    static __device__ __forceinline__ unsigned gq(float v) { return (unsigned)(int)(__builtin_rintf(sigm(v) * 254.0f)) + 1u; }
    __device__ __forceinline__ void operator()(i32x4 (&acc)[2][2][4][2], const Unit& u, int wr, int wc, int fr, int fq) const {
        { asm volatile("" : "+v"(fr), "+v"(fq)); } const int pno = u.pn; const bool sg = ZMAP && pno >= 34;
        const int row0 = u.pm * BM + wr * 64 + fr, col0 = pno * BM + wc * 32 + 8 * fq, ccol0 = u.pn * BM + wc * 32 + 8 * fq;
        f32x4 sw[2][2];
#pragma unroll
        for (int bj = 0; bj < 2; ++bj) { sw[bj][0] = *(const f32x4*)(SW + ccol0 + bj * HALF); sw[bj][1] = *(const f32x4*)(SW + ccol0 + bj * HALF + 4); }
#pragma unroll
        for (int ai = 0; ai < 2; ++ai)
#pragma unroll
            for (int m = 0; m < 4; ++m) { const int r = row0 + ai * HALF + m * 16; const float sa = SA[r]; bf16_t* rowp = O + (size_t)r * ldc + col0;
#pragma unroll
                for (int bj = 0; bj < 2; ++bj) { f32x4 v0, v1;
#pragma unroll
                    for (int j = 0; j < 4; ++j) { v0[j] = (float)acc[ai][bj][m][0][j] * sa * sw[bj][0][j]; v1[j] = (float)acc[ai][bj][m][1][j] * sa * sw[bj][1][j]; }
                    if (sg) { typedef unsigned u32x2_t __attribute__((ext_vector_type(2))); u32x2_t w;
                        w.x = gq(v0[0]) | (gq(v0[1]) << 8) | (gq(v0[2]) << 16) | (gq(v0[3]) << 24); w.y = gq(v1[0]) | (gq(v1[1]) << 8) | (gq(v1[2]) << 16) | (gq(v1[3]) << 24);
                        *(u32x2_t*)(G8 + (size_t)r * 12288 + (col0 - 8704) + bj * HALF) = w; }
                    else { u32x4 w; w.x = pk_bf16(v0[0], v0[1]); w.y = pk_bf16(v0[2], v0[3]); w.z = pk_bf16(v1[0], v1[1]); w.w = pk_bf16(v1[2], v1[3]);
                        *(u32x4*)(rowp + bj * HALF) = w; } } }
    }
};
struct EpiF32P {
    static constexpr bool PERM = false, AFTER_DRAIN = false, HOOK = false, I8 = false; typedef f32x4 acc_t;
    float* C; int ldc;
    __device__ __forceinline__ void hook(f32x4 (&)[2][2][4][2], const Unit&, int, int, int, int, int) const {}
    __device__ __forceinline__ void operator()(f32x4 (&acc)[2][2][4][2], const Unit& u, int wr, int wc, int fr, int fq) const {
        { asm volatile("" : "+v"(fr), "+v"(fq)); } const int row0 = u.pm * BM + wr * 64 + fr, col0 = u.pn * BM + wc * 32 + 4 * fq;
#pragma unroll
        for (int ai = 0; ai < 2; ++ai)
#pragma unroll
            for (int m = 0; m < 4; ++m) { float* rowp = C + (size_t)(row0 + ai * HALF + m * 16) * ldc + col0;
#pragma unroll
                for (int bj = 0; bj < 2; ++bj)
#pragma unroll
                    for (int n = 0; n < 2; ++n) *(f32x4*)(rowp + bj * HALF + n * 16) = acc[ai][bj][m][n]; }
    }
};
struct EpiMerged {
    static constexpr bool PERM = true, AFTER_DRAIN = false, HOOK = true, I8 = false; typedef f32x4 acc_t;
    int hk0, hk1; const unsigned char* G; int ldg; bf16_t* O; int ldo;
    static __device__ __forceinline__ f32x4 ub4(unsigned w) { return (f32x4){(float)(w & 255u), (float)((w >> 8) & 255u), (float)((w >> 16) & 255u), (float)(w >> 24)}; }
    template <bool RATIO> __device__ __forceinline__ void scale(f32x4 (&acc)[2][2][4][2], const Unit& u, int wr, int wc, int fr, int fq, int gate) const {
        typedef unsigned u32x2_t __attribute__((ext_vector_type(2)));
        { asm volatile("" : "+v"(fr), "+v"(fq)); } const unsigned char* gb = G + gate * 4096 + u.pn * BM + wc * 32 + 8 * fq; const int row0 = u.pm * BM + wr * 64 + fr;
#pragma unroll
        for (int ai = 0; ai < 2; ++ai) {
            u32x2_t gv[4][2], gd[4][2];
#pragma unroll
            for (int m = 0; m < 4; ++m)
#pragma unroll
                for (int bj = 0; bj < 2; ++bj) { const unsigned char* gp = gb + (size_t)(row0 + ai * HALF + m * 16) * ldg + bj * HALF; gv[m][bj] = *(const u32x2_t*)gp; if (RATIO) gd[m][bj] = *(const u32x2_t*)(gp + 4096); }
#pragma unroll
            for (int m = 0; m < 4; ++m)
#pragma unroll
                for (int bj = 0; bj < 2; ++bj) { f32x4 f0 = ub4(gv[m][bj].x), f1 = ub4(gv[m][bj].y);
                    if (RATIO) { const f32x4 d0 = ub4(gd[m][bj].x), d1 = ub4(gd[m][bj].y);
#pragma unroll
                        for (int j = 0; j < 4; ++j) { f0[j] *= __builtin_amdgcn_rcpf(d0[j]); f1[j] *= __builtin_amdgcn_rcpf(d1[j]); } }
                    else { f0 = f0 * (1.0f / 255.0f); f1 = f1 * (1.0f / 255.0f); }
                    acc[ai][bj][m][0] *= f0; acc[ai][bj][m][1] *= f1; }
            asm volatile("" ::: "memory");
        }
    }
    __device__ __forceinline__ void hook(f32x4 (&acc)[2][2][4][2], const Unit& u, int t, int wr, int wc, int fr, int fq) const {
        const int b = (t == hk0) ? 0 : 1;
        scale<true>(acc, u, wr, wc, fr, fq, b);
    }
    __device__ __forceinline__ void operator()(f32x4 (&acc)[2][2][4][2], const Unit& u, int wr, int wc, int fr, int fq) const {
        scale<false>(acc, u, wr, wc, fr, fq, 2);
        { asm volatile("" : "+v"(fr), "+v"(fq)); } const int row0 = u.pm * BM + wr * 64 + fr, col0 = u.pn * BM + wc * 32 + 8 * fq;
#pragma unroll
        for (int ai = 0; ai < 2; ++ai)
#pragma unroll
            for (int m = 0; m < 4; ++m) { bf16_t* rowp = O + (size_t)(row0 + ai * HALF + m * 16) * ldo + col0;
#pragma unroll
                for (int bj = 0; bj < 2; ++bj) { const f32x4 v0 = acc[ai][bj][m][0], v1 = acc[ai][bj][m][1];
                    u32x4 w; w.x = pk_bf16(v0[0], v0[1]); w.y = pk_bf16(v0[2], v0[3]); w.z = pk_bf16(v1[0], v1[1]); w.w = pk_bf16(v1[2], v1[3]);
                    *(u32x4*)(rowp + bj * HALF) = w; } }
    }
};
struct EpiOut {
    static constexpr bool PERM = true, AFTER_DRAIN = false, HOOK = false, I8 = false; typedef f32x4 acc_t;
    const float* xp; bf16_t* O; int ld;
    __device__ __forceinline__ void hook(f32x4 (&)[2][2][4][2], const Unit&, int, int, int, int, int) const {}
    __device__ __forceinline__ void operator()(f32x4 (&acc)[2][2][4][2], const Unit& u, int wr, int wc, int fr, int fq) const {
        { asm volatile("" : "+v"(fr), "+v"(fq)); } const int row0 = u.pm * BM + wr * 64 + fr, col0 = u.pn * BM + wc * 32 + 8 * fq;
#pragma unroll
        for (int ai = 0; ai < 2; ++ai) {
            f32x4 xv[4][2][2];
#pragma unroll
            for (int m = 0; m < 4; ++m) { const float* src = xp + (size_t)(row0 + ai * HALF + m * 16) * ld + col0;
#pragma unroll
                for (int bj = 0; bj < 2; ++bj) { xv[m][bj][0] = *(const f32x4*)(src + bj * HALF); xv[m][bj][1] = *(const f32x4*)(src + bj * HALF + 4); } }
#pragma unroll
            for (int m = 0; m < 4; ++m) { bf16_t* dst = O + (size_t)(row0 + ai * HALF + m * 16) * ld + col0;
#pragma unroll
                for (int bj = 0; bj < 2; ++bj) { const f32x4 v0 = xv[m][bj][0] + acc[ai][bj][m][0], v1 = xv[m][bj][1] + acc[ai][bj][m][1];
                    u32x4 w; w.x = pk_bf16(v0[0], v0[1]); w.y = pk_bf16(v0[2], v0[3]); w.z = pk_bf16(v1[0], v1[1]); w.w = pk_bf16(v1[2], v1[3]);
                    *(u32x4*)(dst + bj * HALF) = w; } }
            asm volatile("" ::: "memory");
        }
    }
};
struct EpiB16 {
    static constexpr bool PERM = true, AFTER_DRAIN = false, HOOK = false, I8 = false; typedef f32x4 acc_t;
    bf16_t* O; int ldc;
    __device__ __forceinline__ void hook(f32x4 (&)[2][2][4][2], const Unit&, int, int, int, int, int) const {}
    __device__ __forceinline__ void operator()(f32x4 (&acc)[2][2][4][2], const Unit& u, int wr, int wc, int fr, int fq) const {
        { asm volatile("" : "+v"(fr), "+v"(fq)); } const int row0 = u.pm * BM + wr * 64 + fr, col0 = u.pn * BM + wc * 32 + 8 * fq;
#pragma unroll
        for (int ai = 0; ai < 2; ++ai)
#pragma unroll
            for (int m = 0; m < 4; ++m) { bf16_t* rowp = O + (size_t)(row0 + ai * HALF + m * 16) * ldc + col0;
#pragma unroll
                for (int bj = 0; bj < 2; ++bj) { const f32x4 v0 = acc[ai][bj][m][0], v1 = acc[ai][bj][m][1];
                    u32x4 w; w.x = pk_bf16(v0[0], v0[1]); w.y = pk_bf16(v0[2], v0[3]); w.z = pk_bf16(v1[0], v1[1]); w.w = pk_bf16(v1[2], v1[3]);
                    *(u32x4*)(rowp + bj * HALF) = w; } }
    }
};

template <class Epi, class Sched, bool ALIGN_EPI = false, bool SP2 = false>
__device__ __forceinline__ void gemm_phase(PG8_LAS unsigned char* lds, const Gemm g, const Sched& S, const Epi& E) {
    const int tid = threadIdx.x, wid = __builtin_amdgcn_readfirstlane(tid >> 6), lane = tid & 63, wr = wid >> 2, wc = wid & 3, fr = lane & 15, fq = lane >> 4;
    const int K = g.K, nt = K / BK;
    unsigned voffA[2], voffB[2];
#pragma unroll
    for (int i = 0; i < 2; ++i) { int R, C; stage_rc(tid * 16 + i * 8192, R, C); const int Rb = Epi::PERM ? ((R & ~31) + perm32(R & 31)) : R;
        voffA[i] = (unsigned)(R * K + C) * 2u; voffB[i] = (unsigned)(Rb * K + C) * 2u; }
    const size_t kstep = (size_t)(BK * 2);
    const size_t hstep = (size_t)HALF * K * 2;
    const size_t tstep = 2 * hstep;
    const unsigned ldsw = (unsigned)wid * 1024u;
    const int aoff = lds_byte(wr * 64 + fr, fq * 8), boff = lds_byte(wc * 32 + fr, fq * 8);
#define PG8_SA(b, h) (((b) * 2 + (h)) * HTB)
#define PG8_SB(b, h) ((4 + (b) * 2 + (h)) * HTB)
#define PG8_STAGE(bufoff, gbase, voff) do { _Pragma("unroll") for (int _i = 0; _i < 2; ++_i) \
        __builtin_amdgcn_global_load_lds((const unsigned*)((const char*)(gbase) + (voff)[_i]), (PG8_LAS unsigned*)(lds + (bufoff) + ldsw + _i * 8192), 16, 0, 0); } while (0)
#define PG8_LDA(dst, b, h) do { _Pragma("unroll") for (int m = 0; m < 4; ++m) _Pragma("unroll") for (int k = 0; k < 2; ++k) dst[m][k] = *(const PG8_LAS bf16x8*)(lds + PG8_SA(b, h) + aoff + m * 2048 + k * 1024); } while (0)
#define PG8_LDB(dst, b, h) do { _Pragma("unroll") for (int n = 0; n < 2; ++n) _Pragma("unroll") for (int k = 0; k < 2; ++k) dst[n][k] = *(const PG8_LAS bf16x8*)(lds + PG8_SB(b, h) + boff + n * 2048 + k * 1024); } while (0)
#define PG8_MMA(ai, bj, At, Bt) do { __builtin_amdgcn_s_setprio(1); _Pragma("unroll") for (int m = 0; m < 4; ++m) _Pragma("unroll") for (int n = 0; n < 2; ++n) _Pragma("unroll") for (int k = 0; k < 2; ++k) { \
        if constexpr (Epi::I8) acc[ai][bj][m][n] = __builtin_bit_cast(acc_t, __builtin_amdgcn_mfma_i32_16x16x64_i8(__builtin_bit_cast(i32x4, Bt[n][k]), __builtin_bit_cast(i32x4, At[m][k]), __builtin_bit_cast(i32x4, acc[ai][bj][m][n]), 0, 0, 0)); \
        else acc[ai][bj][m][n] = __builtin_bit_cast(acc_t, __builtin_amdgcn_mfma_f32_16x16x32_bf16(Bt[n][k], At[m][k], __builtin_bit_cast(f32x4, acc[ai][bj][m][n]), 0, 0, 0)); } __builtin_amdgcn_s_setprio(0); } while (0)
#define PG8_WAIT_V(n) asm volatile("s_waitcnt vmcnt(" #n ")" ::: "memory")
#define PG8_WAIT_L(n) asm volatile("s_waitcnt lgkmcnt(" #n ")" ::: "memory")
#define PG8_BAR __builtin_amdgcn_s_barrier()
#define PG8_SCHED __builtin_amdgcn_sched_barrier(0)
    Unit cur, nxt; int ui = 0;
    if (!S.next(0, cur)) return;
    typedef typename Epi::acc_t acc_t;
    acc_t acc[2][2][4][2];
#pragma unroll
    for (int a = 0; a < 2; ++a)
#pragma unroll
        for (int b = 0; b < 2; ++b)
#pragma unroll
            for (int m = 0; m < 4; ++m)
#pragma unroll
                for (int n = 0; n < 2; ++n) acc[a][b][m][n] = acc_t{};
    bf16x8 At[4][2], B0[2][2], B1[2][2];
    const char* cA = (const char*)g.A + (size_t)cur.pm * tstep; const char* cB = (const char*)g.Bt + (size_t)cur.pn * tstep;
    S.a_ready(cur);
    if constexpr (SP2) {
        PG8_STAGE(PG8_SB(0, 0), cB, voffB); PG8_STAGE(PG8_SB(0, 1), cB + hstep, voffB); PG8_STAGE(PG8_SA(0, 0), cA, voffA); PG8_STAGE(PG8_SA(0, 1), cA + hstep, voffA);
        if (wr == 1) PG8_BAR;
        PG8_WAIT_V(2); PG8_BAR;
        PG8_STAGE(PG8_SB(1, 0), cB + kstep, voffB); PG8_STAGE(PG8_SA(1, 0), cA + kstep, voffA); PG8_STAGE(PG8_SB(1, 1), cB + hstep + kstep, voffB);
        PG8_WAIT_V(6); PG8_BAR;
    } else {
        PG8_STAGE(PG8_SB(0, 0), cB, voffB); PG8_STAGE(PG8_SA(0, 0), cA, voffA); PG8_STAGE(PG8_SB(0, 1), cB + hstep, voffB); PG8_STAGE(PG8_SA(0, 1), cA + hstep, voffA);
        if (wr == 1) PG8_BAR;
        PG8_WAIT_V(4); PG8_BAR;
        PG8_STAGE(PG8_SB(1, 0), cB + kstep, voffB); PG8_STAGE(PG8_SA(1, 0), cA + kstep, voffA); PG8_STAGE(PG8_SB(1, 1), cB + hstep + kstep, voffB);
        PG8_WAIT_V(6); PG8_BAR;
    }
    for (;;) {
        const bool has_next = S.next(ui + 1, nxt);
        const char* nA = has_next ? (const char*)g.A + (size_t)nxt.pm * tstep : cA; const char* nB = has_next ? (const char*)g.Bt + (size_t)nxt.pn * tstep : cB;
        for (int t = 0; t < nt; t += 2) {
            const bool last = (t == nt - 2);
            const char* a1 = cA + (size_t)(t + 1) * kstep;
            const char* a2 = last ? nA : cA + (size_t)(t + 2) * kstep; const char* b2 = last ? nB : cB + (size_t)(t + 2) * kstep;
            const char* a3 = a2 + kstep; const char* b3 = b2 + kstep;
            if (last && has_next) S.a_ready(nxt);
            if constexpr (Epi::HOOK) { if (t == E.hk0 || t == E.hk1) E.hook(acc, cur, t, wr, wc, fr, fq); }
            if constexpr (SP2) {
            PG8_LDB(B0, 0, 0); PG8_LDB(B1, 0, 1); PG8_SCHED; PG8_LDA(At, 0, 0); PG8_STAGE(PG8_SA(1, 1), a1 + hstep, voffA);
            PG8_WAIT_V(8); PG8_WAIT_L(0); PG8_BAR; PG8_MMA(0, 0, At, B0); PG8_MMA(0, 1, At, B1); PG8_BAR; PG8_SCHED;
            PG8_LDA(At, 0, 1); PG8_STAGE(PG8_SB(0, 0), b2, voffB); PG8_STAGE(PG8_SB(0, 1), b2 + hstep, voffB); PG8_STAGE(PG8_SA(0, 0), a2, voffA);
            PG8_WAIT_V(8); PG8_WAIT_L(0); PG8_BAR; PG8_MMA(1, 0, At, B0); PG8_MMA(1, 1, At, B1); PG8_BAR; PG8_SCHED;
            PG8_LDB(B0, 1, 0); PG8_LDB(B1, 1, 1); PG8_SCHED; PG8_LDA(At, 1, 0); PG8_STAGE(PG8_SA(0, 1), a2 + hstep, voffA);
            PG8_WAIT_V(8); PG8_WAIT_L(0); PG8_BAR; PG8_MMA(0, 0, At, B0); PG8_MMA(0, 1, At, B1); PG8_BAR; PG8_SCHED;
            PG8_LDA(At, 1, 1); PG8_STAGE(PG8_SB(1, 0), b3, voffB); PG8_STAGE(PG8_SB(1, 1), b3 + hstep, voffB); PG8_STAGE(PG8_SA(1, 0), a3, voffA);
            PG8_WAIT_V(8); PG8_WAIT_L(0); PG8_BAR; PG8_MMA(1, 0, At, B0); PG8_MMA(1, 1, At, B1); PG8_BAR; PG8_SCHED;
            } else {
            PG8_LDB(B0, 0, 0); PG8_SCHED; PG8_LDA(At, 0, 0); PG8_STAGE(PG8_SA(1, 1), a1 + hstep, voffA);
            PG8_WAIT_L(8); PG8_BAR; PG8_WAIT_L(0); PG8_MMA(0, 0, At, B0); PG8_BAR; PG8_SCHED;
            PG8_LDB(B1, 0, 1); PG8_STAGE(PG8_SB(0, 0), b2, voffB);
            PG8_BAR; PG8_WAIT_L(0); PG8_MMA(0, 1, At, B1); PG8_BAR;
            PG8_LDA(At, 0, 1); PG8_STAGE(PG8_SA(0, 0), a2, voffA);
            PG8_BAR; PG8_WAIT_L(0); PG8_MMA(1, 0, At, B0); PG8_BAR; PG8_SCHED;
            PG8_STAGE(PG8_SB(0, 1), b2 + hstep, voffB);
            PG8_WAIT_V(6); PG8_BAR; PG8_MMA(1, 1, At, B1); PG8_BAR;
            PG8_LDB(B0, 1, 0); PG8_SCHED; PG8_LDA(At, 1, 0); PG8_STAGE(PG8_SA(0, 1), a2 + hstep, voffA);
            PG8_WAIT_L(8); PG8_BAR; PG8_WAIT_L(0); PG8_MMA(0, 0, At, B0); PG8_BAR; PG8_SCHED;
            PG8_LDB(B1, 1, 1); PG8_STAGE(PG8_SB(1, 0), b3, voffB);
            PG8_BAR; PG8_WAIT_L(0); PG8_MMA(0, 1, At, B1); PG8_BAR;
            PG8_LDA(At, 1, 1); PG8_STAGE(PG8_SA(1, 0), a3, voffA);
            PG8_BAR; PG8_WAIT_L(0); PG8_MMA(1, 0, At, B0); PG8_BAR; PG8_SCHED;
            PG8_STAGE(PG8_SB(1, 1), b3 + hstep, voffB);
            PG8_WAIT_V(6); PG8_BAR; PG8_MMA(1, 1, At, B1); PG8_BAR;
            }
        }
        if constexpr (ALIGN_EPI) { if (wr == 0) PG8_BAR; }
        if constexpr (!Epi::AFTER_DRAIN) { E(acc, cur, wr, wc, fr, fq); S.done(cur); }
        if (!has_next) break;
#pragma unroll
        for (int a = 0; a < 2; ++a)
#pragma unroll
            for (int b = 0; b < 2; ++b)
#pragma unroll
                for (int m = 0; m < 4; ++m)
#pragma unroll
                    for (int n = 0; n < 2; ++n) acc[a][b][m][n] = acc_t{};
        cur = nxt; cA = nA; cB = nB; ++ui;
        if constexpr (ALIGN_EPI) { if (wr == 1) PG8_BAR; }
    }
    PG8_WAIT_V(0);
    if constexpr (!ALIGN_EPI) { if (wr == 0) PG8_BAR; }
    PG8_BAR;
    if constexpr (Epi::AFTER_DRAIN) { E.fused(acc, cur, wr, wc, fr, fq, lds, wid, lane); S.done(cur); }
#undef PG8_SA
#undef PG8_SB
#undef PG8_STAGE
#undef PG8_LDA
#undef PG8_LDB
#undef PG8_MMA
#undef PG8_WAIT_V
#undef PG8_WAIT_L
#undef PG8_BAR
#undef PG8_SCHED
}
}

constexpr size_t CTL_BYTES = 1u << 20;
constexpr size_t WS_CTL = 0;
constexpr size_t WS_WIN = CTL_BYTES;
constexpr size_t WS_WMKV = WS_WIN + (size_t)INC * DM * 2;
constexpr size_t WS_WCAT = WS_WMKV + (size_t)2048 * DM * 2;
constexpr size_t WS_WOUT = WS_WCAT + (size_t)DM * KCAT * 2;
constexpr size_t WS_WQ = WS_WOUT + (size_t)DM * DM * 2;
constexpr size_t WS_LRUW = WS_WQ + (size_t)PQW * DM * 2;
constexpr size_t WS_SUBK = WS_LRUW + (size_t)24 * 128 * 128 * 2;
constexpr size_t WS_U = WS_SUBK + (size_t)8 * 2 * 128 * 128 * 2;
constexpr size_t WS_V = WS_U + (size_t)PNE * DM * 2;
constexpr size_t WS_XN = WS_V + (size_t)PNE * DM * 2;
constexpr size_t WS_MEMN = WS_XN + (size_t)MALL * DM * 2;
constexpr size_t WS_Z = WS_MEMN + (size_t)1024 * DM * 2;
constexpr size_t WS_QN = WS_Z + (size_t)MALL * INC * 2;
constexpr size_t WS_KN = WS_QN + (size_t)MALL * DILW * 2;
constexpr size_t WS_MQN = WS_KN + (size_t)MALL * DILW * 2;
constexpr size_t WS_MK = WS_MQN + (size_t)MALL * MEMW * 2;
constexpr size_t WS_MV = WS_MK + (size_t)1024 * 1024 * 2;
constexpr size_t WS_HLOC = WS_MV + (size_t)1024 * 1024 * 2;
constexpr size_t WS_PCUM = WS_HLOC + (size_t)MP * LRUW * 4;
constexpr size_t WS_AGG = WS_PCUM + (size_t)MP * LRUW * 4;
constexpr size_t WS_OG = WS_AGG + (size_t)4 * 16 * 1536 * 2 * 4;
constexpr size_t WS_LSE = WS_OG + (size_t)3 * MALL * 512 * 4;
constexpr size_t WS_YCAT = WS_LSE + (size_t)3 * MALL * 4 * 4;
constexpr size_t WS_MERGED = WS_YCAT + (size_t)MALL * KCAT * 2;
constexpr size_t WS_PID = WS_MERGED + (size_t)MALL * DM * 2;
constexpr size_t WS_PW = WS_PID + (size_t)MALL * 128 * 4;
constexpr size_t WS_BIAS = WS_PW + (size_t)MALL * 128 * 4;
constexpr size_t WS_SPLUS = WS_BIAS + 8192;
constexpr size_t WS_MKVRAW = WS_SPLUS + 8192;
constexpr size_t WS_G8 = WS_MKVRAW + (size_t)1024 * 2048 * 4;
constexpr size_t WS_END = WS_G8 + (size_t)MALL * 12288;
constexpr size_t WS_WINB = WS_WIN, WS_WIN8 = WS_WIN + (40u << 20), WS_SW8 = WS_WIN + (123u << 20), WS_XN8 = WS_WIN + (124u << 20), WS_SA = WS_WIN + (158u << 20);
static_assert(WS_SA + (size_t)MALL * 4 <= WS_WMKV && WS_XN8 + (size_t)MALL * DM <= WS_SA && WS_WIN8 + (size_t)INC * DM <= WS_SW8 && WS_SW8 + (size_t)INC * 4 <= WS_XN8, "int8 layout");
constexpr size_t WS_WQ8 = WS_WQ, WS_SWQ = WS_WQ + (8u << 20);
constexpr int CW_CM = 32768, CW_CMQ = CW_CM + INC;
constexpr size_t WS_SU = WS_U + (64u << 20), WS_SV = WS_V + (64u << 20), WS_H2Q = WS_U + (66u << 20), WS_SH = WS_U + (100u << 20);
static_assert(WS_H2Q + (size_t)MALL * DM <= WS_SH && WS_SH + (size_t)MALL * 4 <= WS_V, "quantized layout");
static_assert((size_t)MALL * PQW * 2 <= 2 * (size_t)MALL * DILW * 2, "Q2 overlay");

constexpr size_t OUT_YP = 0;
constexpr size_t OUT_YS = OUT_YP + (size_t)MP * DM;
constexpr size_t OUT_PCONV = OUT_YS + (size_t)MS * DM;
constexpr size_t OUT_PRNN = OUT_PCONV + (size_t)NBATCH * 3 * LRUW;
constexpr size_t OUT_PSWA0 = OUT_PRNN + (size_t)NBATCH * LRUW;
constexpr size_t OUT_PSWA1 = OUT_PSWA0 + (size_t)NBATCH * 128 * 1024;
constexpr size_t OUT_PSWA2 = OUT_PSWA1 + (size_t)NBATCH * 512 * 1024;
constexpr size_t OUT_PMEM = OUT_PSWA2 + (size_t)NBATCH * 2048 * 1024;
constexpr size_t OUT_SCONV = OUT_PMEM + (size_t)NBATCH * 256 * 2048;
constexpr size_t OUT_SRNN = OUT_SCONV + (size_t)MS * 3 * LRUW;
constexpr size_t OUT_SSWA0 = OUT_SRNN + (size_t)MS * LRUW;
constexpr size_t OUT_SSWA1 = OUT_SSWA0 + (size_t)MS * 128 * 1024;
constexpr size_t OUT_SSWA2 = OUT_SSWA1 + (size_t)MS * 512 * 1024;
constexpr size_t OUT_END = OUT_SSWA2 + (size_t)MS * 2048 * 1024;
static_assert(OUT_END == 135094272, "output size");

constexpr int CW_BAR = 4096;
constexpr int CW_CMDONE = 2048;

constexpr int LDS_BYTES = 163840;
constexpr int LDS_MISC = LDS_BYTES - 256;

enum { I_XP = 0, I_XS, I_SCONV, I_SRNN, I_C0, I_C1, I_C2, I_CMEM, I_MEMP, I_RELB, I_N1G, I_WIN, I_CONVW, I_CONVB, I_LWA, I_LBA, I_LWI, I_LBI, I_LAM, I_QNG, I_KNG, I_MNG, I_WMKV, I_MQNG, I_MKNG,
       I_WBA, I_WBB, I_WBM, I_WOUT, I_N2G, I_PWQ, I_PSUB, I_PU, I_PV, N_IN };

#define XB_TMO      128
#define XB_XCNT(j)  (256  + 64 * (j))
#define XB_XSUB(j)  (1280 + 64 * (j))
#define XB_XGEN(j)  (2304 + 64 * (j))
#define XB_TOP      3328
#define XB_TOPGEN   3392
#define XCD_BAR_WORDS 3456
#define XB_SPIN_CAP (1u << 18)

__device__ __forceinline__ unsigned xb_ld(unsigned* p)              { return __hip_atomic_load(p, __ATOMIC_RELAXED, __HIP_MEMORY_SCOPE_AGENT); }
__device__ __forceinline__ unsigned xb_add(unsigned* p, unsigned v) { return __hip_atomic_fetch_add(p, v, __ATOMIC_RELAXED, __HIP_MEMORY_SCOPE_AGENT); }
__device__ __forceinline__ unsigned xb_xcc_id() { return (unsigned)__builtin_amdgcn_s_getreg((3 << 11) | 20) & 0xFu; }
#define XB_SPIN(cond, bar) do { unsigned _sp = 0; while (cond) { __builtin_amdgcn_s_sleep(1); \
    if ((++_sp & 255u) == 0u) { if (xb_ld(&(bar)[XB_TMO])) break; if (_sp > XB_SPIN_CAP) { atomicAdd(&(bar)[XB_TMO], 1u); break; } } } } while (0)

struct XcdBarrier {
    unsigned* bar; unsigned x;
    volatile LAS unsigned* st;
};
__device__ __forceinline__ XcdBarrier xcd_barrier_post(unsigned* bar, volatile LAS unsigned* st) {
    XcdBarrier b; b.bar = bar; b.x = xb_xcc_id(); b.st = st;
    if (threadIdx.x == 0) (void)xb_add(&bar[XB_XCNT(b.x)], 1u);
    return b;
}
__device__ __forceinline__ void xcd_barrier_complete(unsigned* bar, unsigned x, unsigned& nloc, unsigned& nx) {
    const unsigned G = gridDim.x * gridDim.y * gridDim.z;
    unsigned sum, cnt, mine, sp = 0u;
    for (;;) {
        sum = 0u; cnt = 0u; mine = 0u;
#pragma unroll
        for (unsigned j = 0; j < 16; ++j) { const unsigned c = xb_ld(&bar[XB_XCNT(j)]); sum += c; cnt += (c > 0u) ? 1u : 0u; mine = (j == x) ? c : mine; }
        if (sum == G) break;
        __builtin_amdgcn_s_sleep(1);
        if ((++sp & 255u) == 0u) { if (xb_ld(&bar[XB_TMO])) break; if (sp > XB_SPIN_CAP) { atomicAdd(&bar[XB_TMO], 1u); break; } }
    }
    nloc = mine > 0u ? mine : 1u; nx = cnt > 0u ? cnt : 1u;
}
__device__ __forceinline__ void xcd_barrier(const XcdBarrier& b) {
    asm volatile("s_waitcnt vmcnt(0)" ::: "memory");
    __syncthreads();
    if (threadIdx.x == 0) {
        unsigned* bar = b.bar;
        __builtin_amdgcn_s_waitcnt(0);
        unsigned nloc = b.st[0], nx = b.st[1];
        if (nloc == 0u) { xcd_barrier_complete(bar, b.x, nloc, nx); b.st[0] = nloc; b.st[1] = nx; }
        const unsigned old = xb_add(&bar[XB_XSUB(b.x)], 1u);
        const unsigned gen = old / nloc;
        if (old + 1u == (gen + 1u) * nloc) {
            __builtin_amdgcn_fence(__ATOMIC_RELEASE, "agent");
            asm volatile("s_waitcnt vmcnt(0)" ::: "memory");
            const unsigned og = xb_add(&bar[XB_TOP], 1u);
            const unsigned tg = og / nx;
            if (og + 1u == (tg + 1u) * nx) xb_add(&bar[XB_TOPGEN], 1u);
            else XB_SPIN(xb_ld(&bar[XB_TOPGEN]) == tg, bar);
            __builtin_amdgcn_fence(__ATOMIC_ACQUIRE, "agent");
            xb_add(&bar[XB_XGEN(b.x)], 1u);
            asm volatile("s_waitcnt vmcnt(0)" ::: "memory");
        } else {
            XB_SPIN(xb_ld(&bar[XB_XGEN(b.x)]) == gen, bar);
            __builtin_amdgcn_fence(__ATOMIC_ACQUIRE, "agent");
            asm volatile("s_waitcnt vmcnt(0)" ::: "memory");
        }
    }
    __syncthreads();
}

struct Args { const float* in[N_IN]; float* out; unsigned char* ws; int ph_lo, ph_hi, bar_region, pad; };

__device__ __forceinline__ void transpose_item(const float* W, int K, int N, bf16* WT, int ldt, int koff, LAS float* scr, int item, int lane) {
    const int nblk = N / 32, kb = item / nblk, nb = item % nblk, k0 = 64 * kb, n0 = 32 * nb;
#pragma unroll 8
    for (int i = 0; i < 32; ++i) { const int kk = 2 * i + (lane >> 5); scr[kk * 33 + (lane & 31)] = W[(size_t)(k0 + kk) * N + n0 + (lane & 31)]; }
    LDS_WAIT(); asm volatile("" ::: "memory");
    const int c = lane & 7;
#pragma unroll
    for (int j = 0; j < 4; ++j) { const int n = (lane >> 3) + 8 * j; const LAS float* s = scr + (8 * c) * 33 + n;
        u32x4 o; o.x = cvt_pk_bf16(s[0 * 33], s[1 * 33]); o.y = cvt_pk_bf16(s[2 * 33], s[3 * 33]); o.z = cvt_pk_bf16(s[4 * 33], s[5 * 33]); o.w = cvt_pk_bf16(s[6 * 33], s[7 * 33]);
        *(u32x4*)(WT + (size_t)(n0 + n) * ldt + koff + k0 + 8 * c) = o; }
    LDS_WAIT(); asm volatile("" ::: "memory");
}

__device__ __forceinline__ void transpose_tile(const float* W, int K, int N, bf16* WT, int ldt, int koff, LAS unsigned char* T, int item, int tid) {
    const int nblk = N / 256, kb = item / nblk, nb = item % nblk, k0 = 128 * kb, n0 = 256 * nb;
    const int c = tid & 63, rp = tid >> 6;
#pragma unroll
    for (int i = 0; i < 8; ++i) { const int r0 = 16 * i + 2 * rp;
        const f32x4 x = *(const f32x4*)(W + (size_t)(k0 + r0) * N + n0 + 4 * c), y = *(const f32x4*)(W + (size_t)(k0 + r0 + 1) * N + n0 + 4 * c);
        LAS unsigned char* d = T + (4 * c) * 264 + r0 * 2;
        *(LAS unsigned*)(d) = cvt_pk_bf16(x.x, y.x); *(LAS unsigned*)(d + 264) = cvt_pk_bf16(x.y, y.y); *(LAS unsigned*)(d + 528) = cvt_pk_bf16(x.z, y.z); *(LAS unsigned*)(d + 792) = cvt_pk_bf16(x.w, y.w); }
    __syncthreads();
    const int ch = tid & 15, nr = tid >> 4;
#pragma unroll
    for (int i = 0; i < 8; ++i) { const int n = nr + 32 * i; const LAS unsigned* sp = (const LAS unsigned*)(T + n * 264 + ch * 16);
        u32x4 o; o.x = sp[0]; o.y = sp[1]; o.z = sp[2]; o.w = sp[3];
        *(u32x4*)(WT + (size_t)(n0 + n) * ldt + koff + k0 + 8 * ch) = o; }
    __syncthreads();
}

__device__ __forceinline__ void colmax_tile(const float* W, int N, int n0, int k0, unsigned* cm, LAS float* red, int tid) {
    const int c = tid & 63, rp = tid >> 6; float mx[4] = {0.f, 0.f, 0.f, 0.f};
#pragma unroll
    for (int i = 0; i < 8; ++i) { const int r0 = 16 * i + 2 * rp;
        const f32x4 x = *(const f32x4*)(W + (size_t)(k0 + r0) * N + n0 + 4 * c), y = *(const f32x4*)(W + (size_t)(k0 + r0 + 1) * N + n0 + 4 * c);
        mx[0] = fmaxf(mx[0], fmaxf(fabsf(x.x), fabsf(y.x))); mx[1] = fmaxf(mx[1], fmaxf(fabsf(x.y), fabsf(y.y))); mx[2] = fmaxf(mx[2], fmaxf(fabsf(x.z), fabsf(y.z))); mx[3] = fmaxf(mx[3], fmaxf(fabsf(x.w), fabsf(y.w))); }
#pragma unroll
    for (int j = 0; j < 4; ++j) red[rp * 256 + 4 * c + j] = mx[j];
    __syncthreads();
    if (tid < 256) { float m = red[tid];
#pragma unroll
        for (int w = 1; w < 8; ++w) m = fmaxf(m, red[w * 256 + tid]);
        atomicMax(cm + tid, __float_as_uint(m)); }
    __syncthreads();
}
template <bool BF> __device__ __forceinline__ void transpose_tile_q8(const float* W, int N, int n0, int k0, const unsigned* cm, unsigned char* WT8, int nc0, float* sw, LAS unsigned char* T, int tid, bf16* WTB = nullptr) {
    const int c = tid & 63, rp = tid >> 6; float sc[4];
#pragma unroll
    for (int j = 0; j < 4; ++j) sc[j] = 127.0f / fmaxf(__uint_as_float(__hip_atomic_load(cm + 4 * c + j, __ATOMIC_RELAXED, __HIP_MEMORY_SCOPE_AGENT)), 1e-30f);
#pragma unroll
    for (int i = 0; i < 8; ++i) { const int r0 = 16 * i + 2 * rp;
        const f32x4 x = *(const f32x4*)(W + (size_t)(k0 + r0) * N + n0 + 4 * c), y = *(const f32x4*)(W + (size_t)(k0 + r0 + 1) * N + n0 + 4 * c);
        LAS unsigned char* d = T + (4 * c) * 144 + r0;
        *(LAS unsigned short*)(d) = (unsigned short)(((int)rintf(x.x * sc[0]) & 255) | (((int)rintf(y.x * sc[0]) & 255) << 8));
        *(LAS unsigned short*)(d + 144) = (unsigned short)(((int)rintf(x.y * sc[1]) & 255) | (((int)rintf(y.y * sc[1]) & 255) << 8));
        *(LAS unsigned short*)(d + 288) = (unsigned short)(((int)rintf(x.z * sc[2]) & 255) | (((int)rintf(y.z * sc[2]) & 255) << 8));
        *(LAS unsigned short*)(d + 432) = (unsigned short)(((int)rintf(x.w * sc[3]) & 255) | (((int)rintf(y.w * sc[3]) & 255) << 8));
        if (BF) { LAS unsigned char* e = T + 36864 + (4 * c) * 264 + r0 * 2;
            *(LAS unsigned*)(e) = cvt_pk_bf16(x.x, y.x); *(LAS unsigned*)(e + 264) = cvt_pk_bf16(x.y, y.y); *(LAS unsigned*)(e + 528) = cvt_pk_bf16(x.z, y.z); *(LAS unsigned*)(e + 792) = cvt_pk_bf16(x.w, y.w); } }
    __syncthreads();
    const int ch = tid & 7, nr = tid >> 3;
#pragma unroll
    for (int i = 0; i < 4; ++i) { const int n = nr + 64 * i; *(u32x4*)(WT8 + (size_t)(nc0 + n) * DM + k0 + 16 * ch) = *(const LAS u32x4*)(T + n * 144 + ch * 16); }
    if (BF) { const int ch2 = tid & 15, nr2 = tid >> 4;
#pragma unroll
        for (int i = 0; i < 8; ++i) { const int n = nr2 + 32 * i; const LAS unsigned* sp = (const LAS unsigned*)(T + 36864 + n * 264 + ch2 * 16);
            u32x4 o; o.x = sp[0]; o.y = sp[1]; o.z = sp[2]; o.w = sp[3];
            *(u32x4*)(WTB + (size_t)n * DM + k0 + 8 * ch2) = o; } }
    if (k0 == 0 && tid < 256) sw[nc0 + tid] = fmaxf(__uint_as_float(__hip_atomic_load(cm + tid, __ATOMIC_RELAXED, __HIP_MEMORY_SCOPE_AGENT)), 1e-30f) * (1.0f / 127.0f);
    __syncthreads();
}
__device__ __forceinline__ int zmap8(int pn8) { return pn8 < 12 ? pn8 + 6 : pn8 + 18; }
template <bool Q8, bool BF = true> __device__ __forceinline__ void rms_row_bf16(const float* xrow, const float* g, bf16* orow, int lane, unsigned* qrow = nullptr, float* qinv = nullptr) {
    const f32x4* xr = (const f32x4*)xrow + lane; f32x4 v[16]; float s = 0.f;
#pragma unroll
    for (int j = 0; j < 16; ++j) { v[j] = xr[64 * j]; s += (v[j].x * v[j].x + v[j].y * v[j].y) + (v[j].z * v[j].z + v[j].w * v[j].w); }
    const float rstd = 1.0f / sqrtf(wave_sum(s) * (1.0f / DM) + EPS);
    const f32x4* gr = (const f32x4*)g + lane; u32x2* o8 = (u32x2*)orow + lane; float mx = 0.f;
#pragma unroll
    for (int j = 0; j < 16; ++j) { const f32x4 gg = gr[64 * j]; v[j].x = v[j].x * rstd * gg.x; v[j].y = v[j].y * rstd * gg.y; v[j].z = v[j].z * rstd * gg.z; v[j].w = v[j].w * rstd * gg.w;
        if (BF) { u32x2 w; w.x = cvt_pk_bf16(v[j].x, v[j].y); w.y = cvt_pk_bf16(v[j].z, v[j].w); o8[64 * j] = w; }
        if (Q8) mx = fmaxf(mx, fmaxf(fmaxf(fabsf(v[j].x), fabsf(v[j].y)), fmaxf(fabsf(v[j].z), fabsf(v[j].w)))); }
    if (Q8) {
        mx = fmaxf(wave_max(mx), 1e-30f); const float sc = 127.0f / mx;
        if (lane == 0) *qinv = mx * (1.0f / 127.0f);
#pragma unroll
        for (int j = 0; j < 16; ++j) { const int b0 = (int)rintf(v[j].x * sc), b1 = (int)rintf(v[j].y * sc), b2 = (int)rintf(v[j].z * sc), b3 = (int)rintf(v[j].w * sc);
            qrow[64 * j + lane] = (unsigned)(b0 & 255) | ((unsigned)(b1 & 255) << 8) | ((unsigned)(b2 & 255) << 16) | ((unsigned)(b3 & 255) << 24); }
    }
}
__device__ __forceinline__ void rms_row_q8_from_bf16(const bf16* xrow, const float* g, int lane, unsigned* qrow, float* qinv) {
    const u32x2* xr = (const u32x2*)xrow + lane; f32x4 v[16]; float s = 0.f;
#pragma unroll
    for (int j = 0; j < 16; ++j) { const u32x2 w = xr[64 * j]; v[j] = (f32x4){bflo(w.x), bfhi(w.x), bflo(w.y), bfhi(w.y)}; s += (v[j].x * v[j].x + v[j].y * v[j].y) + (v[j].z * v[j].z + v[j].w * v[j].w); }
    const float rstd = 1.0f / sqrtf(wave_sum(s) * (1.0f / DM) + EPS);
    const f32x4* gr = (const f32x4*)g + lane; float mx = 0.f;
#pragma unroll
    for (int j = 0; j < 16; ++j) { const f32x4 gg = gr[64 * j]; v[j].x = v[j].x * rstd * gg.x; v[j].y = v[j].y * rstd * gg.y; v[j].z = v[j].z * rstd * gg.z; v[j].w = v[j].w * rstd * gg.w;
        mx = fmaxf(mx, fmaxf(fmaxf(fabsf(v[j].x), fabsf(v[j].y)), fmaxf(fabsf(v[j].z), fabsf(v[j].w)))); }
    mx = fmaxf(wave_max(mx), 1e-30f); const float sc = 127.0f / mx;
    if (lane == 0) *qinv = mx * (1.0f / 127.0f);
#pragma unroll
    for (int j = 0; j < 16; ++j) { const int b0 = (int)rintf(v[j].x * sc), b1 = (int)rintf(v[j].y * sc), b2 = (int)rintf(v[j].z * sc), b3 = (int)rintf(v[j].w * sc);
        qrow[64 * j + lane] = (unsigned)(b0 & 255) | ((unsigned)(b1 & 255) << 8) | ((unsigned)(b2 & 255) << 16) | ((unsigned)(b3 & 255) << 24); }
}
__device__ __forceinline__ int t5_bucket(int dist) {
    if (dist < 16) return dist;
    const float d = (float)dist; int large = 16 + (int)(logf(d / 16.0f) / 4.852030263919617f * 16.0f);
    return large < 31 ? large : 31;
}
__device__ __forceinline__ void tables_phase(const Args& a, LAS unsigned char* L, int tid, int lane, int wave, int G) {
    unsigned char* ws = a.ws;
    const f32x4* su = (const f32x4*)a.in[I_PU]; const f32x4* sv = (const f32x4*)a.in[I_PV]; u32x4* du = (u32x4*)(ws + WS_U); u32x4* dv = (u32x4*)(ws + WS_V);
        for (int it = blockIdx.x; it < 2 * (PNE / 16); it += G) {
            const bool isv = it >= PNE / 16; const int e0 = 16 * (isv ? it - PNE / 16 : it);
            const f32x4* src = (isv ? sv : su) + (size_t)e0 * (DM / 4); u32x4* dst = isv ? dv : du;
            LAS float* red = (LAS float*)(L + 65536);
            f32x4 p[16], q[16];
#pragma unroll
            for (int i = 0; i < 16; ++i) { const int ch = i * 512 + tid; p[i] = src[2 * ch]; q[i] = src[2 * ch + 1]; }
#pragma unroll
            for (int i = 0; i < 16; ++i) { float m = fmaxf(fmaxf(fmaxf(fabsf(p[i].x), fabsf(p[i].y)), fmaxf(fabsf(p[i].z), fabsf(p[i].w))), fmaxf(fmaxf(fabsf(q[i].x), fabsf(q[i].y)), fmaxf(fabsf(q[i].z), fabsf(q[i].w))));
                m = wave_max(m); if (lane == 0) red[i * 8 + wave] = m; }
            __syncthreads();
#pragma unroll
            for (int i = 0; i < 16; ++i) {
                float m = red[i * 8];
#pragma unroll
                for (int w = 1; w < 8; ++w) m = fmaxf(m, red[i * 8 + w]);
                m = fmaxf(m, 1e-30f);
                const float sc = (isv ? 224.0f : 127.0f) / m;
                if (tid == i) ((float*)(ws + (isv ? WS_SV : WS_SU)))[e0 + i] = m * (isv ? (1.0f / 224.0f) : (1.0f / 127.0f));
                u32x2 w2;
                if (isv) { int a0 = __builtin_amdgcn_cvt_pk_fp8_f32(p[i].x * sc, p[i].y * sc, 0, false); a0 = __builtin_amdgcn_cvt_pk_fp8_f32(p[i].z * sc, p[i].w * sc, a0, true);
                           int a1 = __builtin_amdgcn_cvt_pk_fp8_f32(q[i].x * sc, q[i].y * sc, 0, false); a1 = __builtin_amdgcn_cvt_pk_fp8_f32(q[i].z * sc, q[i].w * sc, a1, true); w2.x = (unsigned)a0; w2.y = (unsigned)a1; }
                else { const int b0 = (int)rintf(p[i].x * sc), b1 = (int)rintf(p[i].y * sc), b2 = (int)rintf(p[i].z * sc), b3 = (int)rintf(p[i].w * sc), b4 = (int)rintf(q[i].x * sc), b5 = (int)rintf(q[i].y * sc), b6 = (int)rintf(q[i].z * sc), b7 = (int)rintf(q[i].w * sc);
                       w2.x = (unsigned)(b0 & 255) | ((unsigned)(b1 & 255) << 8) | ((unsigned)(b2 & 255) << 16) | ((unsigned)(b3 & 255) << 24); w2.y = (unsigned)(b4 & 255) | ((unsigned)(b5 & 255) << 8) | ((unsigned)(b6 & 255) << 16) | ((unsigned)(b7 & 255) << 24); }
                *(LAS u32x2*)(L + (size_t)i * 4096 + tid * 8) = w2;
            }
            __syncthreads();
#pragma unroll
            for (int i = 0; i < 8; ++i) { const int o = i * 512 + tid, sl = o >> 7, rem = o & 127, er = rem >> 3, cc = rem & 7;
                dst[(size_t)sl * ((size_t)PNE * 8) + (size_t)(e0 + er) * 8 + cc] = *(const LAS u32x4*)(L + (size_t)er * 4096 + sl * 128 + cc * 16); }
            __syncthreads();
        }
}
#ifndef PROBE_DOUBLE
#define PROBE_DOUBLE 0
#endif
#define REP0(k) for (int rep0_ = 0; rep0_ < 1 + (((PROBE_DOUBLE) >> (k)) & 1); ++rep0_)
__device__ __forceinline__ void q8_chunk_item(const Args& a, int c, int i, bool tr, LAS unsigned char* L, int tid) {
    unsigned char* ws = a.ws; unsigned* CM = (unsigned*)(ws + WS_CTL) + CW_CM;
    const float* W; int N, n0, k0; unsigned* cm; unsigned char* WT8; float* sw;
    if (c < 10 || i < 64) { const int nt = c < 10 ? 8 : 2; const int kb = i / nt, pn = 8 * c + i % nt; W = a.in[I_WIN]; N = INC; n0 = 256 * pn; k0 = 128 * kb; cm = CM + 256 * pn; WT8 = ws + WS_WIN8; sw = (float*)(ws + WS_SW8); }
    else { const int r = i - 64, kb = r >> 3, pq = r & 7; W = a.in[I_PWQ]; N = PQW; n0 = 256 * pq; k0 = 128 * kb; cm = CM + INC + 256 * pq; WT8 = ws + WS_WQ8; sw = (float*)(ws + WS_SWQ); }
    if (!tr) { colmax_tile(W, N, n0, k0, cm, (LAS float*)L, tid); return; }
    const int pnz = (N == INC) ? (n0 >> 8) : 99;
    if (pnz < 6 || (pnz >= 18 && pnz < 30)) { const int pb = pnz < 6 ? pnz : pnz - 12; transpose_tile_q8<true>(W, N, n0, k0, cm, WT8, n0, sw, L, tid, (bf16*)(ws + WS_WINB) + (size_t)256 * pb * DM); }
    else transpose_tile_q8<false>(W, N, n0, k0, cm, WT8, n0, sw, L, tid);
}
__device__ __forceinline__ void p0_prologue(const Args& a, LAS unsigned char* L, int tid, int lane, int wave, int G) {
    unsigned char* ws = a.ws;
    LAS float* scr = (LAS float*)(L + wave * 16384);
    const int gw = blockIdx.x * 8 + wave, NGW = G * 8;
    REP0(16) {
        unsigned* cnt0 = (unsigned*)(ws + WS_CTL) + CW_CMDONE; unsigned* tmo = (unsigned*)(ws + WS_CTL) + CW_BAR + XB_TMO;
#pragma unroll 1
        for (int c = 0; c <= 11; ++c) {
            if (c < 11) {
                const int ni = c < 10 ? 256 : 320;
                for (int i = blockIdx.x; i < ni; i += G) q8_chunk_item(a, c, i, false, L, tid);
                asm volatile("s_waitcnt vmcnt(0)" ::: "memory"); __syncthreads();
                if (tid == 0) __hip_atomic_fetch_add(cnt0 + 64 * c, 1u, __ATOMIC_RELAXED, __HIP_MEMORY_SCOPE_AGENT);
            }
            if (c >= 1) {
                const int p = c - 1;
                if (tid == 0) { unsigned sp = 0;
                    while (__hip_atomic_load(cnt0 + 64 * p, __ATOMIC_RELAXED, __HIP_MEMORY_SCOPE_AGENT) < (unsigned)G) { __builtin_amdgcn_s_sleep(2);
                        if ((++sp & 255u) == 0u) { if (__hip_atomic_load(tmo, __ATOMIC_RELAXED, __HIP_MEMORY_SCOPE_AGENT)) break; if (sp > (1u << 20)) { atomicAdd(tmo, 1u); break; } } }
                    __builtin_amdgcn_fence(__ATOMIC_ACQUIRE, "agent"); asm volatile("s_waitcnt vmcnt(0)" ::: "memory"); }
                __syncthreads();
                const int ni = p < 10 ? 256 : 320;
                for (int i = blockIdx.x; i < ni; i += G) q8_chunk_item(a, p, i, true, L, tid);
            }
        }
        constexpr int T_INB = 0, T_MKV = (DM / 128) * (2048 / 256), T_BA = (LRUW / 128) * (DM / 256), T_BB = (512 / 128) * (DM / 256), T_BM = (1024 / 128) * (DM / 256), T_OUT = (DM / 128) * (DM / 256);
        constexpr int NTT = T_INB + T_MKV + T_BA + T_BB + T_BM + T_OUT;
        for (int it = G - 1 - (int)blockIdx.x; it < NTT; it += G) {
            int r = it;
            if (r < T_MKV) { transpose_tile(a.in[I_WMKV], DM, 2048, (bf16*)(ws + WS_WMKV), DM, 0, L, r, tid); continue; } r -= T_MKV;
            if (r < T_BA) { transpose_tile(a.in[I_WBA], LRUW, DM, (bf16*)(ws + WS_WCAT), KCAT, 0, L, r, tid); continue; } r -= T_BA;
            if (r < T_BB) { transpose_tile(a.in[I_WBB], 512, DM, (bf16*)(ws + WS_WCAT), KCAT, 1536, L, r, tid); continue; } r -= T_BB;
            if (r < T_BM) { transpose_tile(a.in[I_WBM], 1024, DM, (bf16*)(ws + WS_WCAT), KCAT, 2048, L, r, tid); continue; } r -= T_BM;
            transpose_tile(a.in[I_WOUT], DM, DM, (bf16*)(ws + WS_WOUT), DM, 0, L, r, tid);
        }
        for (int it = NGW - 1 - gw; it < 24 * 8; it += NGW) { const int mj = it >> 3, sub = it & 7; const float* W = (mj < 12 ? a.in[I_LWA] + (size_t)mj * 16384 : a.in[I_LWI] + (size_t)(mj - 12) * 16384);
            transpose_item(W, 128, 128, (bf16*)(ws + WS_LRUW) + (size_t)mj * 16384, 128, 0, scr, sub, lane); }
        __syncthreads();
    }
    if (blockIdx.x == 1 % G) { float* sp = (float*)(ws + WS_SPLUS); for (int i = tid; i < LRUW; i += 512) sp[i] = log1pf(expf(-a.in[I_LAM][i])); }
    REP0(17) for (int m = (gw + NGW - NGW / 4) % NGW; m < MALL + 1024; m += NGW) {
        if (m < MP) rms_row_bf16<true>(a.in[I_XP] + (size_t)m * DM, a.in[I_N1G], (bf16*)(ws + WS_XN) + (size_t)m * DM, lane, (unsigned*)(ws + WS_XN8) + (size_t)m * (DM / 4), (float*)(ws + WS_SA) + m);
        else if (m < MREAL) rms_row_bf16<true>(a.in[I_XS] + (size_t)(m - MP) * DM, a.in[I_N1G], (bf16*)(ws + WS_XN) + (size_t)m * DM, lane, (unsigned*)(ws + WS_XN8) + (size_t)m * (DM / 4), (float*)(ws + WS_SA) + m);
        else if (m < MALL) { u32x4* o = (u32x4*)((bf16*)(ws + WS_XN) + (size_t)m * DM) + lane;
#pragma unroll
            for (int j = 0; j < 8; ++j) o[64 * j] = (u32x4){0u, 0u, 0u, 0u}; }
        else rms_row_bf16<false>(a.in[I_MEMP] + (size_t)(m - MALL) * DM, a.in[I_MNG], (bf16*)(ws + WS_MEMN) + (size_t)(m - MALL) * DM, lane);
    }
}
__device__ __forceinline__ void p0b_prologue(const Args& a, LAS unsigned char* L, int tid, int lane, int wave, int G) {
    unsigned char* ws = a.ws;
    const size_t gt = (size_t)blockIdx.x * 512 + tid, NTH = (size_t)G * 512;
    REP0(18) {
        __syncthreads();
        tables_phase(a, L, tid, lane, wave, G);
        const size_t k8 = (size_t)8 * 2 * 128 * 128 / 8; const f32x4* sk = (const f32x4*)a.in[I_PSUB]; u32x4* dk = (u32x4*)(ws + WS_SUBK);
        for (size_t i = gt; i < k8; i += NTH) { const f32x4 p = sk[2 * i], q = sk[2 * i + 1]; u32x4 w; w.x = cvt_pk_bf16(p.x, p.y); w.y = cvt_pk_bf16(p.z, p.w); w.z = cvt_pk_bf16(q.x, q.y); w.w = cvt_pk_bf16(q.z, q.w); dk[i] = w; }
    }
    REP0(19) {
#pragma unroll
        for (int g = 0; g < 3; ++g) {
            const int Wb = (g == 0) ? 128 : (g == 1) ? 512 : 2048; const size_t per_b = (size_t)(Wb - 1) * 256;
            const f32x4* src = (const f32x4*)a.in[I_C0 + g]; f32x4* dst = (f32x4*)(a.out + ((g == 0) ? OUT_SSWA0 : (g == 1) ? OUT_SSWA1 : OUT_SSWA2));
            const unsigned pb = (unsigned)per_b, tot = pb * MS;
            for (unsigned i0 = (unsigned)gt; i0 < tot; i0 += 8u * (unsigned)NTH) {
                f32x4 t[8]; unsigned di[8];
#pragma unroll
                for (int j = 0; j < 8; ++j) { const unsigned f = i0 + (unsigned)j * (unsigned)NTH; if (f < tot) { const unsigned b = f / pb, rem = f - b * pb; di[j] = b * (unsigned)(Wb * 256) + rem; t[j] = __builtin_nontemporal_load(src + di[j] + 256); } }
#pragma unroll
                for (int j = 0; j < 8; ++j) { const unsigned f = i0 + (unsigned)j * (unsigned)NTH; if (f < tot) __builtin_nontemporal_store(t[j], dst + di[j]); }
            }
        }
        for (size_t i = gt; i < (size_t)MS * 2 * LRUW; i += NTH) { const size_t b = i / (2 * LRUW), rem = i - b * (2 * LRUW); a.out[OUT_SCONV + b * 3 * LRUW + rem] = a.in[I_SCONV][b * 3 * LRUW + LRUW + rem]; }
    }
    if (blockIdx.x == 0) {
        float* bt = (float*)(ws + WS_BIAS);
        for (int i = tid; i < 3 * 129 * 4; i += 512) { const int g = i / (129 * 4), off = (i / 4) % 129, hh = i & 3; const int dil = 1 << (2 * g);
            bt[i] = a.in[I_RELB][t5_bucket(off * dil) * NDH + 4 * g + hh]; }
    }
}

__device__ __forceinline__ void lru_ab(float R, float I, float sp, float xc, float& a, float& b) {
    const float r = sigmoidf_(R), ig = sigmoidf_(I);
    a = fast_exp(-8.0f * r * sp); b = sqrtf(fmaxf(1.0f - a * a, 0.f)) * (ig * xc);
}
__device__ __forceinline__ void lru_local_item(const Args& a, LAS unsigned char* L, int tid, int lane, int wave, int it) {
    unsigned char* ws = a.ws; tid = launder(tid); lane = launder(lane);
    const int b = it / 192, c = (it / 12) % 16, n = it % 12;
    const bf16* Z = (const bf16*)(ws + WS_Z);
    LAS unsigned char* XC = L; LAS unsigned char* WA = L + 34816; LAS unsigned char* WI = L + 69632;
    LAS float* AF = (LAS float*)L; LAS float* BF = (LAS float*)(L + 66048);
    {
        const bf16* wa = (const bf16*)(ws + WS_LRUW) + (size_t)n * 16384; const bf16* wi = (const bf16*)(ws + WS_LRUW) + (size_t)(12 + n) * 16384;
#pragma unroll
        for (int j = 0; j < 4; ++j) { const int task = j * 512 + tid, row = task >> 4, ch = task & 15;
            *(LAS u32x4*)(WA + row * 272 + ch * 16) = *(const u32x4*)(wa + row * 128 + ch * 8);
            *(LAS u32x4*)(WI + row * 272 + ch * 16) = *(const u32x4*)(wi + row * 128 + ch * 8); }
        if (tid < 384) { const int k = tid >> 7, o = tid & 127; const float* srcp = (k == 0) ? a.in[I_LBA] : (k == 1) ? a.in[I_LBI] : (const float*)(ws + WS_SPLUS); ((LAS float*)(L + 132096))[tid] = srcp[128 * n + o]; }
    }
    {
        const int cg = tid & 15; const int chb = 128 * n + 8 * cg;
        float cw[4][8], cb[8];
#pragma unroll
        for (int k = 0; k < 4; ++k) { const f32x4 p = *(const f32x4*)(a.in[I_CONVW] + k * LRUW + chb), q = *(const f32x4*)(a.in[I_CONVW] + k * LRUW + chb + 4);
            cw[k][0] = p.x; cw[k][1] = p.y; cw[k][2] = p.z; cw[k][3] = p.w; cw[k][4] = q.x; cw[k][5] = q.y; cw[k][6] = q.z; cw[k][7] = q.w; }
        { const f32x4 p = *(const f32x4*)(a.in[I_CONVB] + chb), q = *(const f32x4*)(a.in[I_CONVB] + chb + 4); cb[0] = p.x; cb[1] = p.y; cb[2] = p.z; cb[3] = p.w; cb[4] = q.x; cb[5] = q.y; cb[6] = q.z; cb[7] = q.w; }
#pragma unroll
        for (int j = 0; j < 4; ++j) {
            const int tt = 32 * j + (tid >> 4), t = 128 * c + tt;
            float xc[8];
#pragma unroll
            for (int e = 0; e < 8; ++e) xc[e] = cb[e];
            u32x4 xl = (u32x4){0u, 0u, 0u, 0u};
#pragma unroll
            for (int k = 0; k < 4; ++k) { const int ts = t - 3 + k; u32x4 w = (u32x4){0u, 0u, 0u, 0u};
                if (ts >= 0) w = *(const u32x4*)(Z + (size_t)(b * SEQ + ts) * INC + O_LX + chb);
                xc[0] += bflo(w.x) * cw[k][0]; xc[1] += bfhi(w.x) * cw[k][1]; xc[2] += bflo(w.y) * cw[k][2]; xc[3] += bfhi(w.y) * cw[k][3];
                xc[4] += bflo(w.z) * cw[k][4]; xc[5] += bfhi(w.z) * cw[k][5]; xc[6] += bflo(w.w) * cw[k][6]; xc[7] += bfhi(w.w) * cw[k][7];
                if (k == 3) xl = w; }
            u32x4 o; o.x = cvt_pk_bf16(xc[0], xc[1]); o.y = cvt_pk_bf16(xc[2], xc[3]); o.z = cvt_pk_bf16(xc[4], xc[5]); o.w = cvt_pk_bf16(xc[6], xc[7]);
            *(LAS u32x4*)(XC + tt * 272 + cg * 16) = o;
            if (c == 15 && tt >= 125) {
                float* pc = a.out + OUT_PCONV + ((size_t)b * 3 + (tt - 125)) * LRUW + chb;
                *(f32x4*)pc = (f32x4){bflo(xl.x), bfhi(xl.x), bflo(xl.y), bfhi(xl.y)}; *(f32x4*)(pc + 4) = (f32x4){bflo(xl.z), bfhi(xl.z), bflo(xl.w), bfhi(xl.w)}; }
        }
    }
    __syncthreads();
    const int fr = lane & 15, fq = lane >> 4;
    f32x4 ar[8], ai[8];
#pragma unroll
    for (int nt = 0; nt < 8; ++nt) { ar[nt] = (f32x4){0.f, 0.f, 0.f, 0.f}; ai[nt] = (f32x4){0.f, 0.f, 0.f, 0.f}; }
    {
        bf16x8 xf[4];
#pragma unroll
        for (int ks = 0; ks < 4; ++ks) xf[ks] = *(const LAS bf16x8*)(XC + (16 * wave + fr) * 272 + ks * 64 + fq * 16);
#pragma unroll
        for (int nt = 0; nt < 8; ++nt)
#pragma unroll
            for (int ks = 0; ks < 4; ++ks) {
                const bf16x8 wa = *(const LAS bf16x8*)(WA + (16 * nt + fr) * 272 + ks * 64 + fq * 16), wi = *(const LAS bf16x8*)(WI + (16 * nt + fr) * 272 + ks * 64 + fq * 16);
                ar[nt] = __builtin_amdgcn_mfma_f32_16x16x32_bf16(wa, xf[ks], ar[nt], 0, 0, 0);
                ai[nt] = __builtin_amdgcn_mfma_f32_16x16x32_bf16(wi, xf[ks], ai[nt], 0, 0, 0); }
    }
    const int tok = 16 * wave + fr;
    float xv[8][4];
#pragma unroll
    for (int nt = 0; nt < 8; ++nt) { const u32x2 w = *(const LAS u32x2*)(XC + tok * 272 + (16 * nt + 4 * fq) * 2); xv[nt][0] = bflo(w.x); xv[nt][1] = bfhi(w.x); xv[nt][2] = bflo(w.y); xv[nt][3] = bfhi(w.y); }
    __syncthreads();
#pragma unroll
    for (int nt = 0; nt < 8; ++nt) {
        const int o = 16 * nt + 4 * fq, ch = 128 * n + o;
        const LAS float* PR = (const LAS float*)(L + 132096); (void)ch;
        const f32x4 ba = *(const LAS f32x4*)(PR + o), bi = *(const LAS f32x4*)(PR + 128 + o), lam = *(const LAS f32x4*)(PR + 256 + o);
#pragma unroll
        for (int r = 0; r < 4; ++r) { float av, bv; lru_ab(ar[nt][r] + ba[r], ai[nt][r] + bi[r], lam[r], xv[nt][r], av, bv); AF[tok * 129 + o + r] = av; BF[tok * 129 + o + r] = bv; }
    }
    __syncthreads();
    if (tid < 128) {
        float h = 0.f, P = 1.f; bf16* hl = (bf16*)(ws + WS_HLOC) + (size_t)(b * SEQ + 128 * c) * LRUW + 128 * n + tid; bf16* pc = (bf16*)(ws + WS_PCUM) + (size_t)(b * SEQ + 128 * c) * LRUW + 128 * n + tid;
#pragma unroll 4
        for (int tt = 0; tt < 128; ++tt) { const float av = AF[tt * 129 + tid], bv = BF[tt * 129 + tid]; h = av * h + bv; P *= av; const unsigned hp = cvt_pk_bf16(h, P); hl[(size_t)tt * LRUW] = (bf16)(hp & 0xffffu); pc[(size_t)tt * LRUW] = (bf16)(hp >> 16); }
        float* ag = (float*)(ws + WS_AGG) + ((size_t)(b * 16 + c) * LRUW + 128 * n + tid) * 2; ag[0] = P; ag[1] = h;
    }
    __syncthreads();
}
__device__ __forceinline__ void lru_sample_item(const Args& a, LAS unsigned char* L, int tid, int it) {
    unsigned char* ws = a.ws; tid = launder(tid); const bf16* Z = (const bf16*)(ws + WS_Z);
    const int n = it >> 3, bq = it & 7, bl = tid >> 7, o = tid & 127, b = 4 * bq + bl, ch = 128 * n + o;
    LAS float* xs = (LAS float*)L;
    const float zs = bf2f(Z[(size_t)(MP + b) * INC + O_LX + ch]);
    float xc = a.in[I_CONVB][ch];
#pragma unroll
    for (int k = 0; k < 3; ++k) xc += a.in[I_SCONV][((size_t)b * 3 + k) * LRUW + ch] * a.in[I_CONVW][k * LRUW + ch];
    xc += zs * a.in[I_CONVW][3 * LRUW + ch];
    xs[bl * 128 + o] = xc;
    __syncthreads();
    float R = a.in[I_LBA][ch], I = a.in[I_LBI][ch];
    const float* wa = a.in[I_LWA] + (size_t)n * 16384 + o; const float* wi = a.in[I_LWI] + (size_t)n * 16384 + o;
#pragma unroll 16
    for (int i = 0; i < 128; ++i) { const float x = xs[bl * 128 + i]; R += x * wa[i * 128]; I += x * wi[i * 128]; }
    float av, bv; lru_ab(R, I, ((const float*)(ws + WS_SPLUS))[ch], xc, av, bv);
    const float h = av * a.in[I_SRNN][(size_t)b * LRUW + ch] + bv;
    a.out[OUT_SRNN + (size_t)b * LRUW + ch] = h;
    a.out[OUT_SCONV + ((size_t)b * 3 + 2) * LRUW + ch] = zs;
    const float gate = bf2f(Z[(size_t)(MP + b) * INC + O_LG + ch]);
    ((bf16*)(ws + WS_YCAT))[(size_t)(MP + b) * KCAT + ch] = (bf16)(cvt_pk_bf16(h * gelu_tanh(gate), 0.f) & 0xffffu);
    __syncthreads();
}
__device__ __forceinline__ void qknorm_row(const Args& a, int row, int lane) {
    unsigned char* ws = a.ws; lane = launder(lane); const bf16* Zr = (const bf16*)(ws + WS_Z) + (size_t)row * INC;
    const int d0 = 8 * (lane & 15);
    float gq[8], gk[8];
    { const f32x4 p = *(const f32x4*)(a.in[I_QNG] + d0), q = *(const f32x4*)(a.in[I_QNG] + d0 + 4); gq[0] = p.x; gq[1] = p.y; gq[2] = p.z; gq[3] = p.w; gq[4] = q.x; gq[5] = q.y; gq[6] = q.z; gq[7] = q.w; }
    { const f32x4 p = *(const f32x4*)(a.in[I_KNG] + d0), q = *(const f32x4*)(a.in[I_KNG] + d0 + 4); gk[0] = p.x; gk[1] = p.y; gk[2] = p.z; gk[3] = p.w; gk[4] = q.x; gk[5] = q.y; gk[6] = q.z; gk[7] = q.w; }
    const bool prompt = row < MP; const int b = prompt ? row / SEQ : row - MP, t = prompt ? row % SEQ : 0;
    u32x4 wqa[3], wka[3], wva[3], wma[2];
#pragma unroll
    for (int j = 0; j < 3; ++j) { wqa[j] = *(const u32x4*)(Zr + O_Q + 512 * j + 8 * lane); wka[j] = *(const u32x4*)(Zr + O_K + 512 * j + 8 * lane); wva[j] = *(const u32x4*)(Zr + O_V + 512 * j + 8 * lane); }
#pragma unroll
    for (int j = 0; j < 2; ++j) wma[j] = *(const u32x4*)(Zr + O_MQ + 512 * j + 8 * lane);
#pragma unroll
    for (int j = 0; j < 3; ++j) {
        const u32x4 wq = wqa[j], wk = wka[j], wv = wva[j];
        float q[8] = {bflo(wq.x), bfhi(wq.x), bflo(wq.y), bfhi(wq.y), bflo(wq.z), bfhi(wq.z), bflo(wq.w), bfhi(wq.w)};
        float k[8] = {bflo(wk.x), bfhi(wk.x), bflo(wk.y), bfhi(wk.y), bflo(wk.z), bfhi(wk.z), bflo(wk.w), bfhi(wk.w)};
        float sq = 0.f, sk = 0.f;
#pragma unroll
        for (int e = 0; e < 8; ++e) { sq += q[e] * q[e]; sk += k[e] * k[e]; }
#pragma unroll
        for (int o = 1; o < 16; o <<= 1) { sq += __shfl_xor(sq, o); sk += __shfl_xor(sk, o); }
        const float rq = 1.0f / sqrtf(sq * (1.0f / HD) + EPS), rk = 1.0f / sqrtf(sk * (1.0f / HD) + EPS);
#pragma unroll
        for (int e = 0; e < 8; ++e) { q[e] = q[e] * rq * gq[e]; k[e] = k[e] * rk * gk[e]; }
        u32x4 oq, ok; oq.x = cvt_pk_bf16(q[0], q[1]); oq.y = cvt_pk_bf16(q[2], q[3]); oq.z = cvt_pk_bf16(q[4], q[5]); oq.w = cvt_pk_bf16(q[6], q[7]);
        ok.x = cvt_pk_bf16(k[0], k[1]); ok.y = cvt_pk_bf16(k[2], k[3]); ok.z = cvt_pk_bf16(k[4], k[5]); ok.w = cvt_pk_bf16(k[6], k[7]);
        *(u32x4*)((bf16*)(ws + WS_QN) + (size_t)row * DILW + 512 * j + 8 * lane) = oq;
        *(u32x4*)((bf16*)(ws + WS_KN) + (size_t)row * DILW + 512 * j + 8 * lane) = ok;
        const int Wb = (j == 0) ? 128 : (j == 1) ? 512 : 2048;
        float* dst = nullptr;
        if (prompt) { const int r = t - (SEQ - Wb); if (r >= 0) dst = a.out + ((j == 0) ? OUT_PSWA0 : (j == 1) ? OUT_PSWA1 : OUT_PSWA2) + ((size_t)b * Wb + r) * 1024; }
        else dst = a.out + ((j == 0) ? OUT_SSWA0 : (j == 1) ? OUT_SSWA1 : OUT_SSWA2) + ((size_t)b * Wb + (Wb - 1)) * 1024;
        if (dst) {
            *(f32x4*)(dst + 8 * lane) = (f32x4){k[0], k[1], k[2], k[3]}; *(f32x4*)(dst + 8 * lane + 4) = (f32x4){k[4], k[5], k[6], k[7]};
            *(f32x4*)(dst + 512 + 8 * lane) = (f32x4){bflo(wv.x), bfhi(wv.x), bflo(wv.y), bfhi(wv.y)}; *(f32x4*)(dst + 512 + 8 * lane + 4) = (f32x4){bflo(wv.z), bfhi(wv.z), bflo(wv.w), bfhi(wv.w)};
        }
    }
    const int m0 = 8 * (lane & 31);
    float gm[8];
    { const f32x4 p = *(const f32x4*)(a.in[I_MQNG] + m0), q = *(const f32x4*)(a.in[I_MQNG] + m0 + 4); gm[0] = p.x; gm[1] = p.y; gm[2] = p.z; gm[3] = p.w; gm[4] = q.x; gm[5] = q.y; gm[6] = q.z; gm[7] = q.w; }
#pragma unroll
    for (int j = 0; j < 2; ++j) {
        const u32x4 w = wma[j];
        float q[8] = {bflo(w.x), bfhi(w.x), bflo(w.y), bfhi(w.y), bflo(w.z), bfhi(w.z), bflo(w.w), bfhi(w.w)};
        float sq = 0.f;
#pragma unroll
        for (int e = 0; e < 8; ++e) sq += q[e] * q[e];
#pragma unroll
        for (int o = 1; o < 32; o <<= 1) sq += __shfl_xor(sq, o);
        const float rq = 1.0f / sqrtf(sq * (1.0f / MEMD) + EPS);
        u32x4 oq; oq.x = cvt_pk_bf16(q[0] * rq * gm[0], q[1] * rq * gm[1]); oq.y = cvt_pk_bf16(q[2] * rq * gm[2], q[3] * rq * gm[3]);
        oq.z = cvt_pk_bf16(q[4] * rq * gm[4], q[5] * rq * gm[5]); oq.w = cvt_pk_bf16(q[6] * rq * gm[6], q[7] * rq * gm[7]);
        *(u32x4*)((bf16*)(ws + WS_MQN) + (size_t)row * MEMW + 512 * j + 8 * lane) = oq;
    }
}
__device__ __forceinline__ void memkv_row(const Args& a, int row, int lane) {
    unsigned char* ws = a.ws; lane = launder(lane); float* pr = a.out + OUT_PMEM + (size_t)row * 2048; const float* rr = (const float*)(ws + WS_MKVRAW) + (size_t)row * 2048;
    const f32x4 g = *(const f32x4*)(a.in[I_MKNG] + 4 * lane);
    f32x4 ka[4], va[4];
#pragma unroll
    for (int j = 0; j < 4; ++j) { ka[j] = *(const f32x4*)(rr + 256 * j + 4 * lane); va[j] = *(const f32x4*)(rr + 1024 + 256 * j + 4 * lane); }
#pragma unroll
    for (int j = 0; j < 4; ++j) {
        f32x4 k = ka[j];
        const float ss = wave_sum((k.x * k.x + k.y * k.y) + (k.z * k.z + k.w * k.w));
        const float rs = 1.0f / sqrtf(ss * (1.0f / MEMD) + EPS);
        k = k * rs * g;
        *(f32x4*)(pr + 256 * j + 4 * lane) = k;
        u32x2 w; w.x = cvt_pk_bf16(k.x, k.y); w.y = cvt_pk_bf16(k.z, k.w);
        *(u32x2*)((bf16*)(ws + WS_MK) + (size_t)row * 1024 + 256 * j + 4 * lane) = w;
        const f32x4 v = va[j]; *(f32x4*)(pr + 1024 + 256 * j + 4 * lane) = v;
        u32x2 wv; wv.x = cvt_pk_bf16(v.x, v.y); wv.y = cvt_pk_bf16(v.z, v.w);
        *(u32x2*)((bf16*)(ws + WS_MV) + (size_t)row * 1024 + 256 * j + 4 * lane) = wv;
    }
}
__device__ __forceinline__ void p2a_phase(const Args& a, LAS unsigned char* L, int tid, int lane, int wave, int G) {
    for (int it = blockIdx.x; it < 768 + 96; it += G) { if (it < 768) lru_local_item(a, L, tid, lane, wave, it); else lru_sample_item(a, L, tid, it - 768); }
    const int NGW = G * 8, gw = NGW - 1 - ((int)blockIdx.x * 8 + wave);
    for (int m = gw; m < MREAL + 1024; m += NGW) { if (m < MREAL) qknorm_row(a, m, lane); else memkv_row(a, m - MREAL, lane); }
}

constexpr int KLD = 272;
constexpr int VLD = 520;
constexpr int ATT_K = 0, ATT_V = 69632, ATT_B = 2 * 69632;

template <class RowPtr> __device__ __forceinline__ void stage_k(LAS unsigned char* Kl, int tid, RowPtr rowptr) {
#pragma unroll
    for (int j = 0; j < 8; ++j) { const int task = j * 512 + tid, jj = task >> 4, c = task & 15; const bf16* p = rowptr(jj);
        u32x4 w = (u32x4){0u, 0u, 0u, 0u}; if (p) w = *(const u32x4*)(p + 8 * c);
        *(LAS u32x4*)(Kl + jj * KLD + c * 16) = w; }
}
template <class RowPtr> __device__ __forceinline__ void stage_vt(LAS unsigned char* Vl, int tid, RowPtr rowptr) {
#pragma unroll
    for (int j = 0; j < 4; ++j) { const int task = j * 512 + tid, c = task >> 7, p = task & 127; const bf16* p0 = rowptr(2 * p); const bf16* p1 = rowptr(2 * p + 1);
        u32x4 x = (u32x4){0u, 0u, 0u, 0u}, y = (u32x4){0u, 0u, 0u, 0u}; if (p0) x = *(const u32x4*)(p0 + 8 * c); if (p1) y = *(const u32x4*)(p1 + 8 * c);
        LAS unsigned char* d = Vl + (8 * c) * VLD + 4 * p;
        *(LAS unsigned*)(d + 0 * VLD) = (x.x & 0xffffu) | (y.x << 16); *(LAS unsigned*)(d + 1 * VLD) = (x.x >> 16) | (y.x & 0xffff0000u);
        *(LAS unsigned*)(d + 2 * VLD) = (x.y & 0xffffu) | (y.y << 16); *(LAS unsigned*)(d + 3 * VLD) = (x.y >> 16) | (y.y & 0xffff0000u);
        *(LAS unsigned*)(d + 4 * VLD) = (x.z & 0xffffu) | (y.z << 16); *(LAS unsigned*)(d + 5 * VLD) = (x.z >> 16) | (y.z & 0xffff0000u);
        *(LAS unsigned*)(d + 6 * VLD) = (x.w & 0xffffu) | (y.w << 16); *(LAS unsigned*)(d + 7 * VLD) = (x.w >> 16) | (y.w & 0xffff0000u); }
}
typedef short s16x4_t __attribute__((ext_vector_type(4)));
__device__ __forceinline__ u32x2 v_tr_read(const LAS unsigned char* Vl, int jb, int d0, int fr) {
    const LAS unsigned char* p = Vl + (jb + (fr >> 2)) * KLD + (d0 + 4 * (fr & 3)) * 2;
    return __builtin_bit_cast(u32x2, __builtin_amdgcn_ds_read_tr16_b64_v4i16((LAS s16x4_t*)p));
}
__device__ __forceinline__ void dil_item(const Args& a, LAS unsigned char* L, int tid, int lane, int wave, int it) {
    unsigned char* ws = a.ws; tid = launder(tid); lane = launder(lane);
    const int b = it / 192, hd = (it >> 4) % 12, blk = it & 15, g = hd >> 2, hh = hd & 3, dil = 1 << (2 * g), nbk = 16 >> (2 * g), r = blk / nbk, n = blk % nbk;
    const bf16* KN = (const bf16*)(ws + WS_KN); const bf16* QN = (const bf16*)(ws + WS_QN); const bf16* Z = (const bf16*)(ws + WS_Z);
    LAS unsigned char* Kl = L + ATT_K; LAS unsigned char* Vl = L + ATT_V; LAS float* Bl = (LAS float*)(L + ATT_B);
    const int kbase = (n - 1) * 128;
    const int fr = lane & 15, fq = lane >> 4, qi = 16 * wave + fr, w0 = wave & ~1;
    const int qrow = b * SEQ + (n * 128 + qi) * dil + r;
    bf16x8 qf[4];
#pragma unroll
    for (int ks = 0; ks < 4; ++ks) qf[ks] = *(const bf16x8*)(QN + (size_t)qrow * DILW + HD * hd + 32 * ks + 8 * fq);
    stage_k(Kl, tid, [&](int jj) -> const bf16* { const int ki = kbase + jj; return ki >= 0 ? KN + (size_t)(b * SEQ + ki * dil + r) * DILW + HD * hd : nullptr; });
    stage_k(Vl, tid, [&](int jj) -> const bf16* { const int ki = kbase + jj; return ki >= 0 ? Z + (size_t)(b * SEQ + ki * dil + r) * INC + O_V + HD * hd : nullptr; });
    if (tid < 129) Bl[tid] = ((const float*)(ws + WS_BIAS))[(g * 129 + tid) * 4 + hh];
    __syncthreads();
    f32x4 s[10];
#pragma unroll
    for (int c = 0; c < 10; ++c) { s[c] = (f32x4){0.f, 0.f, 0.f, 0.f};
#pragma unroll
        for (int ks = 0; ks < 4; ++ks) { const bf16x8 kf = *(const LAS bf16x8*)(Kl + (16 * (w0 + c) + fr) * KLD + ks * 64 + fq * 16); s[c] = __builtin_amdgcn_mfma_f32_16x16x32_bf16(kf, qf[ks], s[c], 0, 0, 0); } }
    const float scale = 0.08838834764831845f;
    float mx = -3.0e38f;
#pragma unroll
    for (int c = 0; c < 10; ++c)
#pragma unroll
        for (int e = 0; e < 4; ++e) { const int jj = 16 * (w0 + c) + 4 * fq + e, off = qi + 128 - jj; const bool valid = (off >= 0) && (off <= 128) && (kbase + jj >= 0);
            const int oc = off < 0 ? 0 : (off > 128 ? 128 : off);
            const float v = valid ? s[c][e] * scale + Bl[oc] : -3.0e38f; s[c][e] = v; mx = fmaxf(mx, v); }
    mx = fmaxf(mx, __shfl_xor(mx, 16)); mx = fmaxf(mx, __shfl_xor(mx, 32));
    float den = 0.f;
#pragma unroll
    for (int c = 0; c < 10; ++c)
#pragma unroll
        for (int e = 0; e < 4; ++e) { const float p = (s[c][e] > -1.0e38f) ? fast_exp(s[c][e] - mx) : 0.f; s[c][e] = p; den += p; }
    den += __shfl_xor(den, 16); den += __shfl_xor(den, 32);
    f32x4 o[8];
#pragma unroll
    for (int dt = 0; dt < 8; ++dt) o[dt] = (f32x4){0.f, 0.f, 0.f, 0.f};
#pragma unroll
    for (int T = 0; T < 5; ++T) {
        u32x4 pw; pw.x = cvt_pk_bf16(s[2 * T][0], s[2 * T][1]); pw.y = cvt_pk_bf16(s[2 * T][2], s[2 * T][3]); pw.z = cvt_pk_bf16(s[2 * T + 1][0], s[2 * T + 1][1]); pw.w = cvt_pk_bf16(s[2 * T + 1][2], s[2 * T + 1][3]);
        const bf16x8 pf = __builtin_bit_cast(bf16x8, pw);
        const int jb = 16 * (w0 + 2 * T) + 4 * fq;
#pragma unroll
        for (int dt = 0; dt < 8; ++dt) { const u32x2 v0 = v_tr_read(Vl, jb, 16 * dt, fr), v1 = v_tr_read(Vl, jb + 16, 16 * dt, fr); u32x4 vw; vw.x = v0.x; vw.y = v0.y; vw.z = v1.x; vw.w = v1.y;
            o[dt] = __builtin_amdgcn_mfma_f32_16x16x32_bf16(__builtin_bit_cast(bf16x8, vw), pf, o[dt], 0, 0, 0); }
    }
    const float inv = 1.0f / den;
    bf16* og = (bf16*)(ws + WS_OG) + (((size_t)g * MALL + qrow) * 4 + hh) * 128 + 4 * fq;
#pragma unroll
    for (int dt = 0; dt < 8; ++dt) { u32x2 w; w.x = cvt_pk_bf16(o[dt][0] * inv, o[dt][1] * inv); w.y = cvt_pk_bf16(o[dt][2] * inv, o[dt][3] * inv); *(u32x2*)(og + 16 * dt) = w; }
    if (fq == 0) ((float*)(ws + WS_LSE))[((size_t)g * MALL + qrow) * 4 + hh] = mx + logf(den);
    __syncthreads();
}
__device__ __forceinline__ void mem_item(const Args& a, LAS unsigned char* L, int tid, int lane, int wave, int it) {
    unsigned char* ws = a.ws; tid = launder(tid); lane = launder(lane);
    const int b = it >> 6, hm = (it >> 4) & 3, qb = it & 15;
    const bf16* MK = (const bf16*)(ws + WS_MK); const bf16* MV = (const bf16*)(ws + WS_MV); const bf16* MQN = (const bf16*)(ws + WS_MQN);
    LAS unsigned char* Kl = L + ATT_K; LAS unsigned char* Vl = L + ATT_V;
    const int fr = lane & 15, fq = lane >> 4, qrow = b * SEQ + qb * 128 + 16 * wave + fr;
    f32x4 s[16];
#pragma unroll
    for (int c = 0; c < 16; ++c) s[c] = (f32x4){0.f, 0.f, 0.f, 0.f};
#pragma unroll
    for (int half = 0; half < 2; ++half) {
        stage_k(Kl, tid, [&](int jj) -> const bf16* { return MK + (size_t)(b * MEMT + jj) * MEMW + MEMD * hm + 128 * half; });
        if (half == 0) stage_k(Vl, tid, [&](int jj) -> const bf16* { return MV + (size_t)(b * MEMT + jj) * MEMW + MEMD * hm; });
        __syncthreads();
        bf16x8 qf[4];
#pragma unroll
        for (int ks = 0; ks < 4; ++ks) qf[ks] = *(const bf16x8*)(MQN + (size_t)qrow * MEMW + MEMD * hm + 128 * half + 32 * ks + 8 * fq);
#pragma unroll
        for (int c = 0; c < 16; ++c) {
#pragma unroll
            for (int ks = 0; ks < 4; ++ks) { const bf16x8 kf = *(const LAS bf16x8*)(Kl + (16 * c + fr) * KLD + ks * 64 + fq * 16); s[c] = __builtin_amdgcn_mfma_f32_16x16x32_bf16(kf, qf[ks], s[c], 0, 0, 0); }
            asm volatile("" ::: "memory"); }
        __syncthreads();
    }
    const float scale = 0.0625f;
    float mx = -3.0e38f;
#pragma unroll
    for (int c = 0; c < 16; ++c)
#pragma unroll
        for (int e = 0; e < 4; ++e) { s[c][e] *= scale; mx = fmaxf(mx, s[c][e]); }
    mx = fmaxf(mx, __shfl_xor(mx, 16)); mx = fmaxf(mx, __shfl_xor(mx, 32));
    float den = 0.f;
#pragma unroll
    for (int c = 0; c < 16; ++c)
#pragma unroll
        for (int e = 0; e < 4; ++e) { const float p = fast_exp(s[c][e] - mx); s[c][e] = p; den += p; }
    den += __shfl_xor(den, 16); den += __shfl_xor(den, 32);
    const float inv = 1.0f / den;
    u32x4 pw[8];
#pragma unroll
    for (int T = 0; T < 8; ++T) { pw[T].x = cvt_pk_bf16(s[2 * T][0], s[2 * T][1]); pw[T].y = cvt_pk_bf16(s[2 * T][2], s[2 * T][3]); pw[T].z = cvt_pk_bf16(s[2 * T + 1][0], s[2 * T + 1][1]); pw[T].w = cvt_pk_bf16(s[2 * T + 1][2], s[2 * T + 1][3]); }
#pragma unroll
    for (int half = 0; half < 2; ++half) {
        if (half == 1) { stage_k(Vl, tid, [&](int jj) -> const bf16* { return MV + (size_t)(b * MEMT + jj) * MEMW + MEMD * hm + 128; }); __syncthreads(); }
        f32x4 o[8];
#pragma unroll
        for (int dt = 0; dt < 8; ++dt) o[dt] = (f32x4){0.f, 0.f, 0.f, 0.f};
#pragma unroll
        for (int T = 0; T < 8; ++T) { const bf16x8 pf = __builtin_bit_cast(bf16x8, pw[T]); const int jb = 32 * T + 4 * fq;
#pragma unroll
            for (int dt = 0; dt < 8; ++dt) { const u32x2 v0 = v_tr_read(Vl, jb, 16 * dt, fr), v1 = v_tr_read(Vl, jb + 16, 16 * dt, fr); u32x4 vw; vw.x = v0.x; vw.y = v0.y; vw.z = v1.x; vw.w = v1.y;
                o[dt] = __builtin_amdgcn_mfma_f32_16x16x32_bf16(__builtin_bit_cast(bf16x8, vw), pf, o[dt], 0, 0, 0); } }
        bf16* yo = (bf16*)(ws + WS_YCAT) + (size_t)qrow * KCAT + 2048 + MEMD * hm + 128 * half + 4 * fq;
#pragma unroll
        for (int dt = 0; dt < 8; ++dt) { u32x2 w; w.x = cvt_pk_bf16(o[dt][0] * inv, o[dt][1] * inv); w.y = cvt_pk_bf16(o[dt][2] * inv, o[dt][3] * inv); *(u32x2*)(yo + 16 * dt) = w; }
        __syncthreads();
    }
}
__device__ __forceinline__ void lru_fix_item(const Args& a, int it, int lane) {
    unsigned char* ws = a.ws; lane = launder(lane);
    const int b = it / 384, c = (it / 24) % 16, ch = 64 * (it % 24) + lane;
    const float* ag = (const float*)(ws + WS_AGG) + ((size_t)b * 16 * LRUW + ch) * 2;
    float carry = 0.f;
    for (int cc = 0; cc < c; ++cc) { const f32x2 pe = *(const f32x2*)(ag + (size_t)cc * LRUW * 2); carry = pe.x * carry + pe.y; }
    const size_t row0 = (size_t)b * SEQ + 128 * c;
    const bf16* hl = (const bf16*)(ws + WS_HLOC) + row0 * LRUW + ch; const bf16* pc = (const bf16*)(ws + WS_PCUM) + row0 * LRUW + ch;
    const bf16* zg = (const bf16*)(ws + WS_Z) + row0 * INC + O_LG + ch; bf16* yo = (bf16*)(ws + WS_YCAT) + row0 * KCAT + ch;
    float h = 0.f;
    for (int t0 = 0; t0 < 128; t0 += 16) {
        bf16 hv[16], pv[16]; bf16 gv[16];
#pragma unroll
        for (int j = 0; j < 16; ++j) { hv[j] = hl[(size_t)(t0 + j) * LRUW]; pv[j] = pc[(size_t)(t0 + j) * LRUW]; gv[j] = zg[(size_t)(t0 + j) * INC]; }
#pragma unroll
        for (int j = 0; j < 16; ++j) { h = bf2f(hv[j]) + bf2f(pv[j]) * carry; yo[(size_t)(t0 + j) * KCAT] = (bf16)(cvt_pk_bf16(h * gelu_tanh(bf2f(gv[j])), 0.f) & 0xffffu); }
    }
    if (c == 15) a.out[OUT_PRNN + (size_t)b * LRUW + ch] = h;
}
__device__ __forceinline__ void dil_sample_item(const Args& a, int it, int lane) {
    unsigned char* ws = a.ws; lane = launder(lane);
    const int b = it / 12, hd = it % 12, g = hd >> 2, hh = hd & 3, dil = 1 << (2 * g), Wb = (g == 0) ? 128 : (g == 1) ? 512 : 2048, row = MP + b;
    const float* cache = a.in[I_C0 + g] + (size_t)b * Wb * 1024 + hh * 128 + 2 * lane;
    const bf16* Z = (const bf16*)(ws + WS_Z);
    const unsigned qw = *(const unsigned*)((const bf16*)(ws + WS_QN) + (size_t)row * DILW + HD * hd + 2 * lane);
    const float q0 = bflo(qw), q1 = bfhi(qw);
    const float* bias = (const float*)(ws + WS_BIAS) + (size_t)g * 129 * 4 + hh;
    const float scale = 0.08838834764831845f;
    float sc[3] = {-3.0e38f, -3.0e38f, -3.0e38f};
    {
        const unsigned kw = *(const unsigned*)((const bf16*)(ws + WS_KN) + (size_t)row * DILW + HD * hd + 2 * lane);
        const float d = wave_sum(q0 * bflo(kw) + q1 * bfhi(kw)) * scale + bias[0];
        if (lane == 0) sc[0] = d;
    }
#pragma unroll 4
    for (int j = 1; j <= 128; ++j) { const f32x2 kv = *(const f32x2*)(cache + (size_t)(Wb - j * dil) * 1024);
        const float d = wave_sum(q0 * kv.x + q1 * kv.y) * scale + bias[j * 4];
        if (lane == (j & 63)) { if (j < 64) sc[0] = d; else if (j < 128) sc[1] = d; else sc[2] = d; } }
    float mx = wave_max(fmaxf(fmaxf(sc[0], sc[1]), sc[2]));
    float p[3];
#pragma unroll
    for (int k = 0; k < 3; ++k) p[k] = (sc[k] > -1.0e38f) ? fast_exp(sc[k] - mx) : 0.f;
    const float den = wave_sum(p[0] + p[1] + p[2]);
    float o0, o1;
    {   const unsigned vw = *(const unsigned*)(Z + (size_t)row * INC + O_V + HD * hd + 2 * lane); const float pj = __shfl(p[0], 0); o0 = pj * bflo(vw); o1 = pj * bfhi(vw); }
#pragma unroll 4
    for (int j = 1; j <= 128; ++j) { const f32x2 vv = *(const f32x2*)(cache + (size_t)(Wb - j * dil) * 1024 + 512);
        const float pj = __shfl((j < 64) ? p[0] : (j < 128) ? p[1] : p[2], j & 63); o0 += pj * vv.x; o1 += pj * vv.y; }
    const float inv = 1.0f / den;
    *(unsigned*)((bf16*)(ws + WS_OG) + (((size_t)g * MALL + row) * 4 + hh) * 128 + 2 * lane) = cvt_pk_bf16(o0 * inv, o1 * inv);
    if (lane == 0) ((float*)(ws + WS_LSE))[((size_t)g * MALL + row) * 4 + hh] = mx + logf(den);
}
__device__ __forceinline__ void mem_sample_item(const Args& a, int it, int lane) {
    unsigned char* ws = a.ws; lane = launder(lane);
    const int b = it >> 2, hm = it & 3, row = MP + b;
    const float* cache = a.in[I_CMEM] + (size_t)b * MEMT * 2048 + hm * 256 + 4 * lane;
    const u32x2 qw = *(const u32x2*)((const bf16*)(ws + WS_MQN) + (size_t)row * MEMW + MEMD * hm + 4 * lane);
    const float q0 = bflo(qw.x), q1 = bfhi(qw.x), q2 = bflo(qw.y), q3 = bfhi(qw.y);
    float sc[4] = {0.f, 0.f, 0.f, 0.f};
#pragma unroll 4
    for (int m = 0; m < 256; ++m) { const f32x4 kv = *(const f32x4*)(cache + (size_t)m * 2048);
        const float d = wave_sum((q0 * kv.x + q1 * kv.y) + (q2 * kv.z + q3 * kv.w)) * 0.0625f;
        if (lane == (m & 63)) { if (m < 64) sc[0] = d; else if (m < 128) sc[1] = d; else if (m < 192) sc[2] = d; else sc[3] = d; } }
    const float mx = wave_max(fmaxf(fmaxf(sc[0], sc[1]), fmaxf(sc[2], sc[3])));
    float p[4];
#pragma unroll
    for (int k = 0; k < 4; ++k) p[k] = fast_exp(sc[k] - mx);
    const float den = wave_sum((p[0] + p[1]) + (p[2] + p[3]));
    f32x4 o = (f32x4){0.f, 0.f, 0.f, 0.f};
#pragma unroll 4
    for (int m = 0; m < 256; ++m) { const f32x4 vv = *(const f32x4*)(cache + (size_t)m * 2048 + 1024);
        const float pj = __shfl((m < 64) ? p[0] : (m < 128) ? p[1] : (m < 192) ? p[2] : p[3], m & 63); o += vv * pj; }
    const float inv = 1.0f / den;
    u32x2 w; w.x = cvt_pk_bf16(o.x * inv, o.y * inv); w.y = cvt_pk_bf16(o.z * inv, o.w * inv);
    *(u32x2*)((bf16*)(ws + WS_YCAT) + (size_t)row * KCAT + 2048 + MEMD * hm + 4 * lane) = w;
}

template <int D, bool DIL> __device__ __forceinline__ void sample_attn_item(const Args& a, LAS unsigned char* L, int wave, int it) {
    unsigned char* ws = a.ws; const int lane = launder(lane_id()), tid = wave * 64 + lane, gq = lane >> 4, li = lane & 15;
    constexpr int DL = D / 16, NV = DL / 4, KPW = DIL ? 16 : 32;
    LAS float* OL = (LAS float*)L;
    LAS float* ML = (LAS float*)(L + 8 * D * 4);
    int b, hd, g = 0, hh = 0, dil = 1, Wb = 0, row; const float* kbase; float scale; const float* bias = nullptr;
    if (DIL) { b = it / 12; hd = it % 12; g = hd >> 2; hh = hd & 3; dil = 1 << (2 * g); Wb = (g == 0) ? 128 : (g == 1) ? 512 : 2048; row = MP + b;
        kbase = a.in[I_C0 + g] + (size_t)b * Wb * 1024 + hh * 128 + DL * li; scale = 0.08838834764831845f; bias = (const float*)(ws + WS_BIAS) + (size_t)g * 129 * 4 + hh; }
    else { b = it >> 2; hd = it & 3; row = MP + b; kbase = a.in[I_CMEM] + (size_t)b * MEMT * 2048 + hd * 256 + DL * li; scale = 0.0625f; }
    constexpr int KSTR = DIL ? 1024 : 2048, VOFF = DIL ? 512 : 1024;
    float q[DL];
    {   const bf16* qp = DIL ? (const bf16*)(ws + WS_QN) + (size_t)row * DILW + HD * hd + DL * li : (const bf16*)(ws + WS_MQN) + (size_t)row * MEMW + MEMD * hd + DL * li;
#pragma unroll
        for (int e = 0; e < DL; e += 2) { const unsigned w = *(const unsigned*)(qp + e); q[e] = bflo(w); q[e + 1] = bfhi(w); } }
    float mloc = -3.0e38f, lloc = 0.f; float o[DL];
#pragma unroll
    for (int e = 0; e < DL; ++e) o[e] = 0.f;
#pragma unroll
    for (int rd = 0; rd < KPW / 16; ++rd) {
        f32x4 kv[4][NV]; float sc[4];
#pragma unroll
        for (int kk = 0; kk < 4; ++kk) { const int j = KPW * wave + 16 * rd + 4 * gq + kk;
            const float* kp = kbase + (size_t)(DIL ? (Wb - (j + 1) * dil) : j) * KSTR;
#pragma unroll
            for (int v = 0; v < NV; ++v) kv[kk][v] = *(const f32x4*)(kp + 4 * v); }
#pragma unroll
        for (int kk = 0; kk < 4; ++kk) { float d = 0.f;
#pragma unroll
            for (int v = 0; v < NV; ++v) d += (q[4 * v] * kv[kk][v].x + q[4 * v + 1] * kv[kk][v].y) + (q[4 * v + 2] * kv[kk][v].z + q[4 * v + 3] * kv[kk][v].w);
            d += __shfl_xor(d, 1); d += __shfl_xor(d, 2); d += __shfl_xor(d, 4); d += __shfl_xor(d, 8);
            const int j = KPW * wave + 16 * rd + 4 * gq + kk;
            sc[kk] = d * scale + (DIL ? bias[(j + 1) * 4] : 0.f); }
        float mr = fmaxf(fmaxf(sc[0], sc[1]), fmaxf(sc[2], sc[3])); mr = fmaxf(mr, __shfl_xor(mr, 16)); mr = fmaxf(mr, __shfl_xor(mr, 32));
        const float mn = fmaxf(mloc, mr), f = fast_exp(mloc - mn);
        float pr[4], ps = 0.f;
#pragma unroll
        for (int kk = 0; kk < 4; ++kk) { pr[kk] = fast_exp(sc[kk] - mn); ps += pr[kk]; }
        ps += __shfl_xor(ps, 16); ps += __shfl_xor(ps, 32);
        lloc = lloc * f + ps; mloc = mn;
#pragma unroll
        for (int kk = 0; kk < 4; ++kk) { const int j = KPW * wave + 16 * rd + 4 * gq + kk; const float* vp = kbase + (size_t)(DIL ? (Wb - (j + 1) * dil) : j) * KSTR + VOFF;
#pragma unroll
            for (int v = 0; v < NV; ++v) kv[kk][v] = *(const f32x4*)(vp + 4 * v); }
#pragma unroll
        for (int e = 0; e < DL; ++e) o[e] *= f;
#pragma unroll
        for (int kk = 0; kk < 4; ++kk)
#pragma unroll
            for (int v = 0; v < NV; ++v) { o[4 * v] += pr[kk] * kv[kk][v].x; o[4 * v + 1] += pr[kk] * kv[kk][v].y; o[4 * v + 2] += pr[kk] * kv[kk][v].z; o[4 * v + 3] += pr[kk] * kv[kk][v].w; }
    }
#pragma unroll
    for (int e = 0; e < DL; ++e) { o[e] += __shfl_xor(o[e], 16); o[e] += __shfl_xor(o[e], 32); }
    if (DIL && wave == 0) {
        const bf16* kp = (const bf16*)(ws + WS_KN) + (size_t)row * DILW + HD * hd + DL * li; const bf16* vp = (const bf16*)(ws + WS_Z) + (size_t)row * INC + O_V + HD * hd + DL * li;
        float d = 0.f; float vv[DL];
#pragma unroll
        for (int e = 0; e < DL; e += 2) { const unsigned w = *(const unsigned*)(kp + e), x = *(const unsigned*)(vp + e); d += q[e] * bflo(w) + q[e + 1] * bfhi(w); vv[e] = bflo(x); vv[e + 1] = bfhi(x); }
        d += __shfl_xor(d, 1); d += __shfl_xor(d, 2); d += __shfl_xor(d, 4); d += __shfl_xor(d, 8);
        const float s0 = d * scale + bias[0]; const float mn = fmaxf(mloc, s0), f = fast_exp(mloc - mn), p0 = fast_exp(s0 - mn);
        lloc = lloc * f + p0; mloc = mn;
#pragma unroll
        for (int e = 0; e < DL; ++e) o[e] = o[e] * f + p0 * vv[e];
    }
    if (gq == 0) {
#pragma unroll
        for (int e = 0; e < DL; ++e) OL[wave * D + DL * li + e] = o[e];
        if (li == 0) { ML[wave * 2] = mloc; ML[wave * 2 + 1] = lloc; }
    }
    __syncthreads();
    if (tid < D) {
        float M = -3.0e38f;
#pragma unroll
        for (int w = 0; w < 8; ++w) M = fmaxf(M, ML[w * 2]);
        float Ls = 0.f, ov = 0.f;
#pragma unroll
        for (int w = 0; w < 8; ++w) { const float f = fast_exp(ML[w * 2] - M); Ls += ML[w * 2 + 1] * f; ov += OL[w * D + tid] * f; }
        ov /= Ls;
        if (DIL) { ((bf16*)(ws + WS_OG))[(((size_t)g * MALL + row) * 4 + hh) * 128 + tid] = (bf16)(cvt_pk_bf16(ov, 0.f) & 0xffffu); if (tid == 0) ((float*)(ws + WS_LSE))[((size_t)g * MALL + row) * 4 + hh] = M + logf(Ls); }
        else ((bf16*)(ws + WS_YCAT))[(size_t)row * KCAT + 2048 + MEMD * hd + tid] = (bf16)(cvt_pk_bf16(ov, 0.f) & 0xffffu);
    }
    __syncthreads();
}

__device__ __forceinline__ void dil_sample_wave(const Args& a, int it, int lane) {
    unsigned char* ws = a.ws; lane = launder(lane); const int gq = lane >> 4, li = lane & 15;
    const int b = it / 12, hd = it % 12, g = hd >> 2, hh = hd & 3, dil = 1 << (2 * g), Wb = (g == 0) ? 128 : (g == 1) ? 512 : 2048, row = MP + b;
    const float* kbase = a.in[I_C0 + g] + (size_t)b * Wb * 1024 + hh * 128 + 8 * li; const float scale = 0.08838834764831845f; const float* bias = (const float*)(ws + WS_BIAS) + (size_t)g * 129 * 4 + hh;
    float q[8];
    {   const u32x4 w = *(const u32x4*)((const bf16*)(ws + WS_QN) + (size_t)row * DILW + HD * hd + 8 * li);
        q[0] = bflo(w.x); q[1] = bfhi(w.x); q[2] = bflo(w.y); q[3] = bfhi(w.y); q[4] = bflo(w.z); q[5] = bfhi(w.z); q[6] = bflo(w.w); q[7] = bfhi(w.w); }
    float mloc = -3.0e38f, lloc = 0.f, o[8];
#pragma unroll
    for (int e = 0; e < 8; ++e) o[e] = 0.f;
    for (int rd = 0; rd < 8; ++rd) {
        f32x4 kk[4][2], vv[4][2];
#pragma unroll
        for (int c = 0; c < 4; ++c) { const int j = 16 * rd + 4 * gq + c; const float* kp = kbase + (size_t)(Wb - (j + 1) * dil) * 1024;
            kk[c][0] = *(const f32x4*)kp; kk[c][1] = *(const f32x4*)(kp + 4); vv[c][0] = *(const f32x4*)(kp + 512); vv[c][1] = *(const f32x4*)(kp + 516); }
        float sc[4];
#pragma unroll
        for (int c = 0; c < 4; ++c) { float d = (q[0] * kk[c][0].x + q[1] * kk[c][0].y) + (q[2] * kk[c][0].z + q[3] * kk[c][0].w) + (q[4] * kk[c][1].x + q[5] * kk[c][1].y) + (q[6] * kk[c][1].z + q[7] * kk[c][1].w);
            d += __shfl_xor(d, 1); d += __shfl_xor(d, 2); d += __shfl_xor(d, 4); d += __shfl_xor(d, 8);
            sc[c] = d * scale + bias[(16 * rd + 4 * gq + c + 1) * 4]; }
        float mr = fmaxf(fmaxf(sc[0], sc[1]), fmaxf(sc[2], sc[3])); mr = fmaxf(mr, __shfl_xor(mr, 16)); mr = fmaxf(mr, __shfl_xor(mr, 32));
        const float mn = fmaxf(mloc, mr), f = fast_exp(mloc - mn);
        float pr[4], ps = 0.f;
#pragma unroll
        for (int c = 0; c < 4; ++c) { pr[c] = fast_exp(sc[c] - mn); ps += pr[c]; }
        ps += __shfl_xor(ps, 16); ps += __shfl_xor(ps, 32);
        lloc = lloc * f + ps; mloc = mn;
#pragma unroll
        for (int e = 0; e < 8; ++e) o[e] *= f;
#pragma unroll
        for (int c = 0; c < 4; ++c) { o[0] += pr[c] * vv[c][0].x; o[1] += pr[c] * vv[c][0].y; o[2] += pr[c] * vv[c][0].z; o[3] += pr[c] * vv[c][0].w; o[4] += pr[c] * vv[c][1].x; o[5] += pr[c] * vv[c][1].y; o[6] += pr[c] * vv[c][1].z; o[7] += pr[c] * vv[c][1].w; }
    }
#pragma unroll
    for (int e = 0; e < 8; ++e) { o[e] += __shfl_xor(o[e], 16); o[e] += __shfl_xor(o[e], 32); }
    {
        const u32x4 kw = *(const u32x4*)((const bf16*)(ws + WS_KN) + (size_t)row * DILW + HD * hd + 8 * li), vw = *(const u32x4*)((const bf16*)(ws + WS_Z) + (size_t)row * INC + O_V + HD * hd + 8 * li);
        float d = (q[0] * bflo(kw.x) + q[1] * bfhi(kw.x)) + (q[2] * bflo(kw.y) + q[3] * bfhi(kw.y)) + (q[4] * bflo(kw.z) + q[5] * bfhi(kw.z)) + (q[6] * bflo(kw.w) + q[7] * bfhi(kw.w));
        d += __shfl_xor(d, 1); d += __shfl_xor(d, 2); d += __shfl_xor(d, 4); d += __shfl_xor(d, 8);
        const float s0 = d * scale + bias[0], mn = fmaxf(mloc, s0), f = fast_exp(mloc - mn), p0 = fast_exp(s0 - mn);
        lloc = lloc * f + p0; mloc = mn;
        const float v8[8] = {bflo(vw.x), bfhi(vw.x), bflo(vw.y), bfhi(vw.y), bflo(vw.z), bfhi(vw.z), bflo(vw.w), bfhi(vw.w)};
#pragma unroll
        for (int e = 0; e < 8; ++e) o[e] = o[e] * f + p0 * v8[e];
    }
    if (gq == 0) { const float inv = 1.0f / lloc; u32x4 w; w.x = cvt_pk_bf16(o[0] * inv, o[1] * inv); w.y = cvt_pk_bf16(o[2] * inv, o[3] * inv); w.z = cvt_pk_bf16(o[4] * inv, o[5] * inv); w.w = cvt_pk_bf16(o[6] * inv, o[7] * inv);
        *(u32x4*)((bf16*)(ws + WS_OG) + (((size_t)g * MALL + row) * 4 + hh) * 128 + 8 * li) = w;
        if (li == 0) ((float*)(ws + WS_LSE))[((size_t)g * MALL + row) * 4 + hh] = mloc + logf(lloc); }
}
__device__ __forceinline__ void p2b_phase(const Args& a, LAS unsigned char* L, int tid, int lane, int wave, int G) {
    for (int it = blockIdx.x; it < 768 + 256 + 128; it += G) {
        if (it < 768) dil_item(a, L, tid, lane, wave, it); else if (it < 1024) mem_item(a, L, tid, lane, wave, it - 768); else sample_attn_item<256, false>(a, L, wave, it - 1024);
    }
    const int gw = blockIdx.x * 8 + wave, NGW = G * 8;
    for (int it = gw; it < 1536 + 384; it += NGW) { if (it < 1536) lru_fix_item(a, it, lane); else dil_sample_wave(a, it - 1536, lane); }
}
__device__ __forceinline__ void combine_row(const Args& a, int row, int lane) {
    unsigned char* ws = a.ws; lane = launder(lane); const int hh = lane >> 4;
    const float* ls = (const float*)(ws + WS_LSE);
    const float l0 = ls[((size_t)0 * MALL + row) * 4 + hh], l1 = ls[((size_t)1 * MALL + row) * 4 + hh], l2 = ls[((size_t)2 * MALL + row) * 4 + hh];
    const float m = fmaxf(l0, fmaxf(l1, l2)); float w0 = fast_exp(l0 - m), w1 = fast_exp(l1 - m), w2 = fast_exp(l2 - m); const float inv = 1.0f / (w0 + w1 + w2); w0 *= inv; w1 *= inv; w2 *= inv;
    const bf16* og = (const bf16*)(ws + WS_OG) + (size_t)row * 512 + 8 * lane;
    const u32x4 ra = *(const u32x4*)og, rb = *(const u32x4*)(og + (size_t)MALL * 512), rc = *(const u32x4*)(og + (size_t)2 * MALL * 512);
    const f32x4 a0 = (f32x4){bflo(ra.x), bfhi(ra.x), bflo(ra.y), bfhi(ra.y)}, a1 = (f32x4){bflo(ra.z), bfhi(ra.z), bflo(ra.w), bfhi(ra.w)};
    const f32x4 b0 = (f32x4){bflo(rb.x), bfhi(rb.x), bflo(rb.y), bfhi(rb.y)}, b1 = (f32x4){bflo(rb.z), bfhi(rb.z), bflo(rb.w), bfhi(rb.w)};
    const f32x4 c0 = (f32x4){bflo(rc.x), bfhi(rc.x), bflo(rc.y), bfhi(rc.y)}, c1 = (f32x4){bflo(rc.z), bfhi(rc.z), bflo(rc.w), bfhi(rc.w)};
    const f32x4 y0 = a0 * w0 + b0 * w1 + c0 * w2, y1 = a1 * w0 + b1 * w1 + c1 * w2;
    u32x4 w; w.x = cvt_pk_bf16(y0.x, y0.y); w.y = cvt_pk_bf16(y0.z, y0.w); w.z = cvt_pk_bf16(y1.x, y1.y); w.w = cvt_pk_bf16(y1.z, y1.w);
    *(u32x4*)((bf16*)(ws + WS_YCAT) + (size_t)row * KCAT + 1536 + 8 * lane) = w;
}

__device__ __forceinline__ float* x2_row(const Args& a, int row) { return row < MP ? a.out + OUT_YP + (size_t)row * DM : a.out + OUT_YS + (size_t)(row - MP) * DM; }
__device__ __forceinline__ void ins16(float (&v)[16], float x) {
#pragma unroll
    for (int k = 15; k >= 1; --k) v[k] = __builtin_amdgcn_fmed3f(x, v[k], v[k - 1]);
    v[0] = fmaxf(x, v[0]);
}
__device__ __forceinline__ float tag_key(float f, unsigned mask, unsigned idx) { return __uint_as_float((__float_as_uint(f) & ~mask) | idx); }
constexpr int TKR = 144;
__device__ __forceinline__ void topk_item(const Args& a, LAS unsigned char* L, int tid, int lane, int wave, int it) {
    unsigned char* ws = a.ws; tid = launder(tid); lane = launder(lane);
    const int tb = it >> 3, h = it & 7; const bool extra = tb < 2;
    const bf16* Q2 = (const bf16*)(ws + WS_QN); const bf16* SK = (const bf16*)(ws + WS_SUBK) + (size_t)h * 2 * 128 * 128;
    LAS unsigned char* QT = L; LAS unsigned char* KT = L + TKR * 528;
    LAS float* S = (LAS float*)L;
    LAS float* LV = (LAS float*)L; LAS int* LI = (LAS int*)(L + 2 * TKR * 16 * 4);
#pragma unroll
    for (int j = 0; j < 8; ++j) { const int task = j * 512 + tid, tt = task >> 5, c = task & 31; *(LAS u32x4*)(QT + tt * 528 + c * 16) = *(const u32x4*)(Q2 + (size_t)(tb * 128 + tt) * PQW + 256 * h + 8 * c); }
    { const int tt = 128 + (tid >> 5), c = tid & 31; *(LAS u32x4*)(QT + tt * 528 + c * 16) = *(const u32x4*)(Q2 + (size_t)(MP + (extra ? 16 * tb : 0) + (tid >> 5)) * PQW + 256 * h + 8 * c); }
#pragma unroll
    for (int j = 0; j < 8; ++j) { const int task = j * 512 + tid, rr = task >> 4, c = task & 15; *(LAS u32x4*)(KT + rr * 272 + c * 16) = *(const u32x4*)(SK + (size_t)rr * 128 + 8 * c); }
    __syncthreads();
    const int fr = lane & 15, fq = lane >> 4, p = wave >> 2;
    f32x4 acc[3][8];
#pragma unroll
    for (int mi = 0; mi < 3; ++mi) { const int mt = (mi < 2) ? 2 * (wave & 3) + mi : 8;
        if (mi == 2 && !(extra && (wave & 3) == 0)) break;
        bf16x8 qf[4];
#pragma unroll
        for (int ks = 0; ks < 4; ++ks) qf[ks] = *(const LAS bf16x8*)(QT + (16 * mt + fr) * 528 + (128 * p + 32 * ks + 8 * fq) * 2);
#pragma unroll
        for (int nt = 0; nt < 8; ++nt) { acc[mi][nt] = (f32x4){0.f, 0.f, 0.f, 0.f};
#pragma unroll
            for (int ks = 0; ks < 4; ++ks) { const bf16x8 kf = *(const LAS bf16x8*)(KT + (128 * p + 16 * nt + fr) * 272 + ks * 64 + fq * 16); acc[mi][nt] = __builtin_amdgcn_mfma_f32_16x16x32_bf16(kf, qf[ks], acc[mi][nt], 0, 0, 0); } } }
    __syncthreads();
#pragma unroll
    for (int mi = 0; mi < 3; ++mi) { const int tok = 16 * ((mi < 2) ? 2 * (wave & 3) + mi : 8) + fr;
        if (mi == 2 && !(extra && (wave & 3) == 0)) break;
#pragma unroll
        for (int nt = 0; nt < 8; ++nt)
#pragma unroll
            for (int e = 0; e < 4; ++e) S[(p * TKR + tok) * 129 + 16 * nt + 4 * fq + e] = acc[mi][nt][e]; }
    __syncthreads();
    float val[16]; int idx[16];
    const bool t1 = tid < 256 || (extra && tid < 288);
    const int sp = tid < 256 ? (tid >> 7) : ((tid - 256) >> 4), stok = tid < 256 ? (tid & 127) : 128 + ((tid - 256) & 15);
    if (t1) {
        const LAS float* sr = S + (sp * TKR + stok) * 129;
        float v[16];
#pragma unroll
        for (int k = 0; k < 16; ++k) v[k] = -3.0e38f;
#pragma unroll 4
        for (int key = 0; key < 128; ++key) ins16(v, tag_key(sr[key], 0x7Fu, (unsigned)key));
#pragma unroll
        for (int k = 0; k < 16; ++k) { idx[k] = (int)(__float_as_uint(v[k]) & 0x7Fu); val[k] = sr[idx[k]]; }
    }
    __syncthreads();
    if (t1) {
#pragma unroll
        for (int k = 0; k < 16; ++k) { LV[(sp * TKR + stok) * 16 + k] = val[k]; LI[(sp * TKR + stok) * 16 + k] = idx[k]; }
    }
    __syncthreads();
    if (tid < 128 || (extra && tid < TKR)) {
        float s1[16], s2[16];
#pragma unroll
        for (int k = 0; k < 16; ++k) { s1[k] = LV[tid * 16 + k]; s2[k] = LV[(TKR + tid) * 16 + k]; }
        float wf[16]; unsigned w[16];
#pragma unroll
        for (int k = 0; k < 16; ++k) wf[k] = -3.0e38f;
#pragma unroll
        for (int i = 0; i < 16; ++i)
#pragma unroll
            for (int j = 0; j < 16; ++j) if ((i + 1) * (j + 1) <= 16) ins16(wf, tag_key(s1[i] + s2[j], 0xFFu, (unsigned)(i * 16 + j)));
#pragma unroll
        for (int k = 0; k < 16; ++k) w[k] = __float_as_uint(wf[k]);
        float sv[16]; int id[16]; float mx = -3.0e38f;
#pragma unroll
        for (int k = 0; k < 16; ++k) { const int i = (w[k] >> 4) & 15, j = w[k] & 15; sv[k] = LV[tid * 16 + i] + LV[(TKR + tid) * 16 + j]; id[k] = LI[tid * 16 + i] * PNK + LI[(TKR + tid) * 16 + j]; mx = fmaxf(mx, sv[k]); }
        float den = 0.f;
#pragma unroll
        for (int k = 0; k < 16; ++k) { sv[k] = fast_exp(sv[k] - mx); den += sv[k]; }
        const float inv = 1.0f / den; const int row = tid < 128 ? tb * 128 + tid : MP + 16 * tb + (tid - 128);
        int* pid = (int*)(ws + WS_PID) + (size_t)row * 128 + 16 * h; float* pw = (float*)(ws + WS_PW) + (size_t)row * 128 + 16 * h;
#pragma unroll
        for (int k = 0; k < 16; k += 4) { *(int4*)(pid + k) = make_int4(id[k], id[k + 1], id[k + 2], id[k + 3]); *(f32x4*)(pw + k) = (f32x4){sv[k] * inv, sv[k + 1] * inv, sv[k + 2] * inv, sv[k + 3] * inv}; }
    }
    __syncthreads();
}
__device__ __forceinline__ void gather_row(const Args& a, int row, int lane) {
    unsigned char* ws = a.ws; lane = launder(lane);
    const bf16* U = (const bf16*)(ws + WS_U); const bf16* V = (const bf16*)(ws + WS_V);
    u32x4 hf[8];
    { const u32x4* hp = (const u32x4*)((const bf16*)(ws + WS_XN) + (size_t)row * DM) + lane;
#pragma unroll
      for (int j = 0; j < 8; ++j) hf[j] = hp[64 * j]; }
    const int* pid = (const int*)(ws + WS_PID) + (size_t)row * 128; const float* pw = (const float*)(ws + WS_PW) + (size_t)row * 128;
    const int id0 = pid[lane], id1 = pid[64 + lane]; const float w0 = pw[lane], w1 = pw[64 + lane];
    float o[8][8];
#pragma unroll
    for (int j = 0; j < 8; ++j)
#pragma unroll
        for (int e = 0; e < 8; ++e) o[j][e] = 0.f;
    for (int pr = 0; pr < 128; pr += 2) {
        int e0, e1; float g0, g1;
        if (pr < 64) { e0 = __builtin_amdgcn_readlane(id0, pr); e1 = __builtin_amdgcn_readlane(id0, pr + 1); g0 = __builtin_bit_cast(float, __builtin_amdgcn_readlane(__builtin_bit_cast(int, w0), pr)); g1 = __builtin_bit_cast(float, __builtin_amdgcn_readlane(__builtin_bit_cast(int, w0), pr + 1)); }
        else { e0 = __builtin_amdgcn_readlane(id1, pr - 64); e1 = __builtin_amdgcn_readlane(id1, pr - 63); g0 = __builtin_bit_cast(float, __builtin_amdgcn_readlane(__builtin_bit_cast(int, w1), pr - 64)); g1 = __builtin_bit_cast(float, __builtin_amdgcn_readlane(__builtin_bit_cast(int, w1), pr - 63)); }
        const u32x4* up0 = (const u32x4*)(U + (size_t)e0 * DM) + lane; const u32x4* up1 = (const u32x4*)(U + (size_t)e1 * DM) + lane;
        u32x4 ua[8], ub[8];
#pragma unroll
        for (int j = 0; j < 8; ++j) { ua[j] = up0[64 * j]; ub[j] = up1[64 * j]; }
        float d0 = 0.f, d1 = 0.f;
#pragma unroll
        for (int j = 0; j < 8; ++j) {
            const u32x4 hh = hf[j];
            d0 += bflo(hh.x) * bflo(ua[j].x) + bfhi(hh.x) * bfhi(ua[j].x) + bflo(hh.y) * bflo(ua[j].y) + bfhi(hh.y) * bfhi(ua[j].y) + bflo(hh.z) * bflo(ua[j].z) + bfhi(hh.z) * bfhi(ua[j].z) + bflo(hh.w) * bflo(ua[j].w) + bfhi(hh.w) * bfhi(ua[j].w);
            d1 += bflo(hh.x) * bflo(ub[j].x) + bfhi(hh.x) * bfhi(ub[j].x) + bflo(hh.y) * bflo(ub[j].y) + bfhi(hh.y) * bfhi(ub[j].y) + bflo(hh.z) * bflo(ub[j].z) + bfhi(hh.z) * bfhi(ub[j].z) + bflo(hh.w) * bflo(ub[j].w) + bfhi(hh.w) * bfhi(ub[j].w);
        }
#pragma unroll
        for (int s = 1; s < 64; s <<= 1) { d0 += __shfl_xor(d0, s); d1 += __shfl_xor(d1, s); }
        const float c0 = g0 * gelu_tanh(d0), c1 = g1 * gelu_tanh(d1);
        asm volatile("" ::: "memory");
        const u32x4* vp0 = (const u32x4*)(V + (size_t)e0 * DM) + lane; const u32x4* vp1 = (const u32x4*)(V + (size_t)e1 * DM) + lane;
#pragma unroll
        for (int j = 0; j < 8; ++j) { ua[j] = vp0[64 * j]; ub[j] = vp1[64 * j]; }
#pragma unroll
        for (int j = 0; j < 8; ++j) {
            o[j][0] += c0 * bflo(ua[j].x) + c1 * bflo(ub[j].x); o[j][1] += c0 * bfhi(ua[j].x) + c1 * bfhi(ub[j].x);
            o[j][2] += c0 * bflo(ua[j].y) + c1 * bflo(ub[j].y); o[j][3] += c0 * bfhi(ua[j].y) + c1 * bfhi(ub[j].y);
            o[j][4] += c0 * bflo(ua[j].z) + c1 * bflo(ub[j].z); o[j][5] += c0 * bfhi(ua[j].z) + c1 * bfhi(ub[j].z);
            o[j][6] += c0 * bflo(ua[j].w) + c1 * bflo(ub[j].w); o[j][7] += c0 * bfhi(ua[j].w) + c1 * bfhi(ub[j].w);
        }
    }
    float* y = x2_row(a, row) + 8 * lane;
#pragma unroll
    for (int j = 0; j < 8; ++j) { f32x4 p = *(f32x4*)(y + 512 * j), q = *(f32x4*)(y + 512 * j + 4);
        p.x += o[j][0]; p.y += o[j][1]; p.z += o[j][2]; p.w += o[j][3]; q.x += o[j][4]; q.y += o[j][5]; q.z += o[j][6]; q.w += o[j][7];
        *(f32x4*)(y + 512 * j) = p; *(f32x4*)(y + 512 * j + 4) = q; }
}


__device__ __forceinline__ float dot8_bf16(const u32x4 h, const u32x4 u, float acc) {
    typedef __bf16 bfx2 __attribute__((ext_vector_type(2)));
    const unsigned h0 = h.x, h1 = h.y, h2 = h.z, h3 = h.w, u0 = u.x, u1 = u.y, u2 = u.z, u3 = u.w;
    acc = __builtin_amdgcn_fdot2_f32_bf16(__builtin_bit_cast(bfx2, h0), __builtin_bit_cast(bfx2, u0), acc, false);
    acc = __builtin_amdgcn_fdot2_f32_bf16(__builtin_bit_cast(bfx2, h1), __builtin_bit_cast(bfx2, u1), acc, false);
    acc = __builtin_amdgcn_fdot2_f32_bf16(__builtin_bit_cast(bfx2, h2), __builtin_bit_cast(bfx2, u2), acc, false);
    acc = __builtin_amdgcn_fdot2_f32_bf16(__builtin_bit_cast(bfx2, h3), __builtin_bit_cast(bfx2, u3), acc, false);
    return acc;
}
__device__ __forceinline__ float rs8(const float (&av)[8], int lg) {
    const bool b0 = lg & 1, b1 = lg & 2, b2 = lg & 4;
    float k4[4];
#pragma unroll
    for (int k = 0; k < 4; ++k) { const float snd = b0 ? av[k] : av[4 + k], kp = b0 ? av[4 + k] : av[k]; k4[k] = kp + __shfl_xor(snd, 8); }
    float k2[2];
#pragma unroll
    for (int k = 0; k < 2; ++k) { const float snd = b1 ? k4[k] : k4[2 + k], kp = b1 ? k4[2 + k] : k4[k]; k2[k] = kp + __shfl_xor(snd, 16); }
    const float snd = b2 ? k2[0] : k2[1], kp = b2 ? k2[1] : k2[0];
    return kp + __shfl_xor(snd, 32);
}
__device__ __forceinline__ void peer_gather_phase(const Args& a, LAS unsigned char* L, int wave, int G) {
    unsigned char* ws = a.ws;
    LAS int* VO = (LAS int*)L;
    LAS float* CW = (LAS float*)(L + 16896);
    LAS float* OX = (LAS float*)(L + 33792);
    const char* U = (const char*)(ws + WS_U); const char* V = (const char*)(ws + WS_V); const char* HQ = (const char*)(ws + WS_H2Q);
    for (int grp = blockIdx.x; grp < MP / 32; grp += G) {
        const int lane = launder(lane_id()), tid = wave * 64 + lane, l8 = lane & 7, lg = lane >> 3;
        static_assert(MP / 32 == 8 * MS, "one 16-expert piece of a sample row per workgroup");
        const int row0 = grp * 32; const int xr = MP + (grp >> 3), pc = grp & 7;
        for (int i = tid; i < 33 * 128; i += 512) { const int tk = i >> 7; const int r = tk < 32 ? row0 + tk : xr; const int col = tk < 32 ? (i & 127) : 16 * pc + (i & 15);
            VO[i] = ((const int*)(ws + WS_PID))[(size_t)r * 128 + col] * 128; CW[i] = ((const float*)(ws + WS_PW))[(size_t)r * 128 + col]; }
        for (int i = tid; i < DM; i += 512) OX[i] = 0.f;
        __syncthreads();
        {
            int acc[66];
#pragma unroll
            for (int j = 0; j < 66; ++j) acc[j] = 0;
            const char* hb = HQ + (size_t)(row0 + 4 * wave) * DM + 16 * l8; const char* hx = HQ + (size_t)xr * DM + 16 * l8;
#ifndef GPROBE
#define GPROBE 0
#endif
            for (int gp_ = 0; gp_ < (GPROBE == 1 ? 2 : 1); ++gp_) {
            if (GPROBE == 1) {
#pragma unroll
                for (int j = 0; j < 66; ++j) acc[j] = 0; }
            for (int s = 0; s < 32; ++s) {
                const char* ub = U + (size_t)s * (PNE * 128); const unsigned lo = (unsigned)l8 * 16u;
                u32x4 bufA[8], bufB[8], bufC[8], hrT[3];
#define GU_ISSUE(buf, b) do { if ((b) < 8) { const int tk_ = (b) >> 1, hf_ = (b) & 1; if (hf_ == 0) hrT[tk_ % 3] = *(const u32x4*)(hb + (size_t)tk_ * DM + 128 * s); \
        _Pragma("unroll") for (int it = 0; it < 8; ++it) { const unsigned vo = (unsigned)VO[(4 * wave + tk_) * 128 + (8 * hf_ + it) * 8 + lg] + lo; buf[it] = *(const u32x4*)(ub + vo); } } \
    else { hrT[1] = *(const u32x4*)(hx + 128 * s); _Pragma("unroll") for (int x = 0; x < 2; ++x) { const unsigned vo = (unsigned)VO[32 * 128 + (2 * wave + x) * 8 + lg] + lo; buf[x] = *(const u32x4*)(ub + vo); } } \
    asm volatile("" ::: "memory"); } while (0)
#define GU_DOT(c, hr, u) do { c = __builtin_amdgcn_sdot4((int)hr.x, (int)u.x, c, false); c = __builtin_amdgcn_sdot4((int)hr.y, (int)u.y, c, false); c = __builtin_amdgcn_sdot4((int)hr.z, (int)u.z, c, false); c = __builtin_amdgcn_sdot4((int)hr.w, (int)u.w, c, false); } while (0)
#define GU_USE(buf, b) do { if ((b) < 8) { const int q_ = ((b) >> 1) * 16 + 8 * ((b) & 1); const u32x4 h_ = hrT[((b) >> 1) % 3]; _Pragma("unroll") for (int it = 0; it < 8; ++it) GU_DOT(acc[q_ + it], h_, buf[it]); \
        asm volatile("" : "+v"(acc[q_]), "+v"(acc[q_ + 1]), "+v"(acc[q_ + 2]), "+v"(acc[q_ + 3]), "+v"(acc[q_ + 4]), "+v"(acc[q_ + 5]), "+v"(acc[q_ + 6]), "+v"(acc[q_ + 7]) :: "memory"); } \
    else { const u32x4 h_ = hrT[1]; GU_DOT(acc[64], h_, buf[0]); GU_DOT(acc[65], h_, buf[1]); asm volatile("" : "+v"(acc[64]), "+v"(acc[65]) :: "memory"); } } while (0)
                GU_ISSUE(bufA, 0); GU_ISSUE(bufB, 1);
                GU_ISSUE(bufC, 2); GU_USE(bufA, 0);
                GU_ISSUE(bufA, 3); GU_USE(bufB, 1);
                GU_ISSUE(bufB, 4); GU_USE(bufC, 2);
                GU_ISSUE(bufC, 5); GU_USE(bufA, 3);
                GU_ISSUE(bufA, 6); GU_USE(bufB, 4);
                GU_ISSUE(bufB, 7); GU_USE(bufC, 5);
                if (wave == 0) { GU_ISSUE(bufC, 8); } GU_USE(bufA, 6);
                GU_USE(bufB, 7);
                if (wave == 0) { GU_USE(bufC, 8); }
#undef GU_ISSUE
#undef GU_USE
#undef GU_DOT
            }
            }
            const float* SU = (const float*)(ws + WS_SU); const float* SV = (const float*)(ws + WS_SV); const float* SH = (const float*)(ws + WS_SH);
#pragma unroll
            for (int j = 0; j < 66; ++j) {
                if (j >= 64 && wave != 0) continue;
                int di = acc[j]; di += __shfl_xor(di, 1); di += __shfl_xor(di, 2); di += __shfl_xor(di, 4);
                const int idx = (j < 64) ? (4 * wave + (j >> 4)) * 128 + (j & 15) * 8 + lg : 32 * 128 + (2 * wave + (j - 64)) * 8 + lg;
                const int e = VO[idx] >> 7; const int r = (j < 64) ? row0 + 4 * wave + (j >> 4) : xr;
                const float d = (float)di * SH[r] * SU[e];
                if (l8 == 0) CW[idx] = CW[idx] * gelu_tanh(d) * SV[e];
            }
        }
        LDS_WAIT();
        {
            const int jsel = 4 * (lg & 1) + 2 * ((lg >> 1) & 1) + ((lg >> 2) & 1);
            for (int gp_ = 0; gp_ < (GPROBE == 2 ? 2 : 1); ++gp_) {
            const bool st_ = (GPROBE != 2) || gp_ == 1;
            for (int s = 0; s < 32; ++s) {
                const char* vb = V + (size_t)s * (PNE * 128); const unsigned lo = (unsigned)l8 * 16u;
                u32x4 bufA[8], bufB[8]; float cfA[8], cfB[8]; float* ypT[2]; float yoT[2][2]; float av[16];
#define GV_ISSUE(buf, cf, b) do { if ((b) < 8) { const int tk_ = (b) >> 1, hf_ = (b) & 1; \
        if (hf_ == 0) { const int r_ = row0 + 4 * wave + tk_; ypT[tk_ & 1] = x2_row(a, r_) + 128 * s + 16 * l8 + jsel; const bf16* xb_ = (const bf16*)(ws + WS_XN) + (size_t)r_ * DM + 128 * s + 16 * l8 + jsel; yoT[tk_ & 1][0] = bf2f(xb_[0]); yoT[tk_ & 1][1] = bf2f(xb_[8]); } \
        _Pragma("unroll") for (int it = 0; it < 8; ++it) { const int idx = (4 * wave + tk_) * 128 + (8 * hf_ + it) * 8 + lg; const unsigned vo = (unsigned)VO[idx] + lo; cf[it] = CW[idx]; buf[it] = *(const u32x4*)(vb + vo); } } \
    else { _Pragma("unroll") for (int x = 0; x < 2; ++x) { const int idx = 32 * 128 + (2 * wave + x) * 8 + lg; const unsigned vo = (unsigned)VO[idx] + lo; cf[x] = CW[idx]; buf[x] = *(const u32x4*)(vb + vo); } } \
    asm volatile("" ::: "memory"); } while (0)
#define GV_FMA(C_, W_) do { const float c = (C_); const u32x4 wq_ = (W_); const unsigned w0 = wq_.x, w1 = wq_.y, w2 = wq_.z, w3 = wq_.w; f32x2 t; \
        t = __builtin_amdgcn_cvt_pk_f32_fp8((int)w0, false); av[0] += c * t.x; av[1] += c * t.y; t = __builtin_amdgcn_cvt_pk_f32_fp8((int)w0, true); av[2] += c * t.x; av[3] += c * t.y; \
        t = __builtin_amdgcn_cvt_pk_f32_fp8((int)w1, false); av[4] += c * t.x; av[5] += c * t.y; t = __builtin_amdgcn_cvt_pk_f32_fp8((int)w1, true); av[6] += c * t.x; av[7] += c * t.y; \
        t = __builtin_amdgcn_cvt_pk_f32_fp8((int)w2, false); av[8] += c * t.x; av[9] += c * t.y; t = __builtin_amdgcn_cvt_pk_f32_fp8((int)w2, true); av[10] += c * t.x; av[11] += c * t.y; \
        t = __builtin_amdgcn_cvt_pk_f32_fp8((int)w3, false); av[12] += c * t.x; av[13] += c * t.y; t = __builtin_amdgcn_cvt_pk_f32_fp8((int)w3, true); av[14] += c * t.x; av[15] += c * t.y; } while (0)
#define GV_PIN() do { asm volatile("" : "+v"(av[0]), "+v"(av[1]), "+v"(av[2]), "+v"(av[3]), "+v"(av[4]), "+v"(av[5]), "+v"(av[6]), "+v"(av[7]) :: "memory"); \
        asm volatile("" : "+v"(av[8]), "+v"(av[9]), "+v"(av[10]), "+v"(av[11]), "+v"(av[12]), "+v"(av[13]), "+v"(av[14]), "+v"(av[15]) :: "memory"); } while (0)
#define GV_USE(buf, cf, b) do { if ((b) < 8) { const int tk_ = (b) >> 1, hf_ = (b) & 1; if (hf_ == 0) { _Pragma("unroll") for (int e = 0; e < 16; ++e) av[e] = 0.f; } \
        _Pragma("unroll") for (int it = 0; it < 8; ++it) GV_FMA(cf[it], buf[it]); GV_PIN(); \
        if (hf_ == 1) { const float alo[8] = {av[0], av[1], av[2], av[3], av[4], av[5], av[6], av[7]}, ahi[8] = {av[8], av[9], av[10], av[11], av[12], av[13], av[14], av[15]}; \
            const float r0_ = yoT[tk_ & 1][0] + rs8(alo, lg), r1_ = yoT[tk_ & 1][1] + rs8(ahi, lg); if (st_) { ypT[tk_ & 1][0] = r0_; ypT[tk_ & 1][8] = r1_; } else if (r0_ == 1.2345e30f) ypT[tk_ & 1][0] = r1_; asm volatile("" ::: "memory"); } } \
    else { _Pragma("unroll") for (int e = 0; e < 16; ++e) av[e] = 0.f; GV_FMA(cf[0], buf[0]); GV_FMA(cf[1], buf[1]); \
        const float alo[8] = {av[0], av[1], av[2], av[3], av[4], av[5], av[6], av[7]}, ahi[8] = {av[8], av[9], av[10], av[11], av[12], av[13], av[14], av[15]}; const float r0 = rs8(alo, lg), r1 = rs8(ahi, lg); \
        if (st_) { __hip_atomic_fetch_add(OX + 128 * s + 16 * l8 + jsel, r0, __ATOMIC_RELAXED, __HIP_MEMORY_SCOPE_WORKGROUP); __hip_atomic_fetch_add(OX + 128 * s + 16 * l8 + 8 + jsel, r1, __ATOMIC_RELAXED, __HIP_MEMORY_SCOPE_WORKGROUP); } else if (r0 == 1.2345e30f) OX[0] = r1; } } while (0)
                GV_ISSUE(bufA, cfA, 0);
                GV_ISSUE(bufB, cfB, 1); GV_USE(bufA, cfA, 0);
                GV_ISSUE(bufA, cfA, 2); GV_USE(bufB, cfB, 1);
                GV_ISSUE(bufB, cfB, 3); GV_USE(bufA, cfA, 2);
                GV_ISSUE(bufA, cfA, 4); GV_USE(bufB, cfB, 3);
                GV_ISSUE(bufB, cfB, 5); GV_USE(bufA, cfA, 4);
                GV_ISSUE(bufA, cfA, 6); GV_USE(bufB, cfB, 5);
                GV_ISSUE(bufB, cfB, 7); GV_USE(bufA, cfA, 6);
                if (wave == 0) { GV_ISSUE(bufA, cfA, 8); } GV_USE(bufB, cfB, 7);
                if (wave == 0) { GV_USE(bufA, cfA, 8); }
#undef GV_ISSUE
#undef GV_FMA
#undef GV_PIN
#undef GV_USE
            }
            }
        }
        __syncthreads();
        { float* y = x2_row(a, xr); for (int i = tid; i < DM; i += 512) unsafeAtomicAdd(y + i, OX[i]); }
        __syncthreads();
    }
}

template <int NSEG, bool I8, class Epi> __device__ __forceinline__ void skinny16(const void* A_, int lda, const void* Bt_, int ldb, int n0, int nks, int ks1, int ks2, LAS float* red, int wave, Epi epi) {
    const int lane = launder(lane_id()), tid = wave * 64 + lane, fr = lane & 15, fq = lane >> 4;
    typedef int i32x4_t __attribute__((ext_vector_type(4)));
    f32x4 acc[NSEG][2]; i32x4_t iacc[NSEG][2];
#pragma unroll
    for (int sg = 0; sg < NSEG; ++sg) { acc[sg][0] = (f32x4){0.f, 0.f, 0.f, 0.f}; acc[sg][1] = (f32x4){0.f, 0.f, 0.f, 0.f}; iacc[sg][0] = (i32x4_t){0, 0, 0, 0}; iacc[sg][1] = (i32x4_t){0, 0, 0, 0}; }
    const char* bp = (const char*)Bt_ + (size_t)(n0 + fr) * ldb + 16 * fq; const char* ap0 = (const char*)A_ + (size_t)fr * lda + 16 * fq; const char* ap1 = (const char*)A_ + (size_t)(16 + fr) * lda + 16 * fq;
#pragma unroll 8
    for (int ks = wave; ks < nks; ks += 8) {
        const bf16x8 bf = *(const bf16x8*)(bp + 64 * ks), a0 = *(const bf16x8*)(ap0 + 64 * ks), a1 = *(const bf16x8*)(ap1 + 64 * ks);
        const int sg = (NSEG == 1) ? 0 : (ks < ks1 ? 0 : (ks < ks2 ? 1 : 2));
#pragma unroll
        for (int q = 0; q < NSEG; ++q) if (q == sg) {
            if (I8) { iacc[q][0] = __builtin_amdgcn_mfma_i32_16x16x64_i8(__builtin_bit_cast(i32x4_t, bf), __builtin_bit_cast(i32x4_t, a0), iacc[q][0], 0, 0, 0); iacc[q][1] = __builtin_amdgcn_mfma_i32_16x16x64_i8(__builtin_bit_cast(i32x4_t, bf), __builtin_bit_cast(i32x4_t, a1), iacc[q][1], 0, 0, 0); }
            else { acc[q][0] = __builtin_amdgcn_mfma_f32_16x16x32_bf16(bf, a0, acc[q][0], 0, 0, 0); acc[q][1] = __builtin_amdgcn_mfma_f32_16x16x32_bf16(bf, a1, acc[q][1], 0, 0, 0); }
        }
    }
#pragma unroll
    for (int sg = 0; sg < NSEG; ++sg)
#pragma unroll
        for (int mi = 0; mi < 2; ++mi)
#pragma unroll
            for (int r = 0; r < 4; ++r) red[((wave * NSEG + sg) * 2 + mi) * 256 + (4 * fq + r) * 16 + fr] = I8 ? (float)iacc[sg][mi][r] : acc[sg][mi][r];
    __syncthreads();
    {
        const int m = tid >> 4, n = tid & 15; float P[3] = {0.f, 0.f, 0.f};
#pragma unroll
        for (int sg = 0; sg < NSEG; ++sg)
#pragma unroll
            for (int w = 0; w < 8; ++w) P[sg] += red[((w * NSEG + sg) * 2 + (m >> 4)) * 256 + n * 16 + (m & 15)];
        epi(m, n0 + n, P[0], P[1], P[2]);
    }
    __syncthreads();
}

__device__ __forceinline__ void p1_skinny_i8_stream(const Args& a, LAS float* red, int wave, int q0, int qs) {
    typedef int i32x4_t __attribute__((ext_vector_type(4)));
    unsigned char* ws = a.ws;
    const int lane = launder(lane_id()), tid = wave * 64 + lane, fr = lane & 15, fq = lane >> 4;
    const char* A = (const char*)(ws + WS_XN8) + (size_t)MP * DM; const char* ap0 = A + (size_t)fr * DM + 16 * fq + 64 * wave; const char* ap1 = ap0 + (size_t)16 * DM;
    const float sa = ((const float*)(ws + WS_SA))[MP + (tid >> 4)];
    i32x4_t bf[8], a0[8], a1[8];
#define SKS_N0(q) (256 * (((q) >> 4) < 12 ? ((q) >> 4) + 6 : ((q) >> 4) + 18) + 16 * ((q) & 15))
#define SKS_LOAD(q) do { const char* bp = (const char*)(ws + WS_WIN8) + (size_t)(SKS_N0(q) + fr) * DM + 16 * fq + 64 * wave; \
        _Pragma("unroll") for (int j = 0; j < 8; ++j) { bf[j] = *(const i32x4_t*)(bp + 512 * j); a0[j] = *(const i32x4_t*)(ap0 + 512 * j); a1[j] = *(const i32x4_t*)(ap1 + 512 * j); } } while (0)
    if (q0 < 1024) SKS_LOAD(q0);
#pragma unroll 1
    for (int q = q0; q < 1024; q += qs) {
        const int n = SKS_N0(q) + (tid & 15), m = tid >> 4;
        const float scl = sa * ((const float*)(ws + WS_SW8))[n];
        i32x4_t c0 = (i32x4_t){0, 0, 0, 0}, c1 = (i32x4_t){0, 0, 0, 0};
#pragma unroll
        for (int j = 0; j < 8; ++j) { c0 = __builtin_amdgcn_mfma_i32_16x16x64_i8(bf[j], a0[j], c0, 0, 0, 0); c1 = __builtin_amdgcn_mfma_i32_16x16x64_i8(bf[j], a1[j], c1, 0, 0, 0); }
        asm volatile("" : "+v"(c0), "+v"(c1) :: "memory");
        const int qn = q + qs;
        if (qn < 1024) SKS_LOAD(qn);
        asm volatile("" ::: "memory");
#pragma unroll
        for (int r = 0; r < 4; ++r) { red[(wave * 2 + 0) * 256 + (4 * fq + r) * 16 + fr] = (float)c0[r]; red[(wave * 2 + 1) * 256 + (4 * fq + r) * 16 + fr] = (float)c1[r]; }
        __syncthreads();
        { float P = 0.f;
#pragma unroll
          for (int w = 0; w < 8; ++w) P += red[(w * 2 + (m >> 4)) * 256 + (tid & 15) * 16 + (m & 15)];
          const float v = P * scl;
          if (n >= O_GATE) (ws + WS_G8)[(size_t)(MP + m) * 12288 + (n - O_GATE)] = (unsigned char)((unsigned)(int)rintf(sigmoidf_(v) * 254.0f) + 1u);
          else ((bf16*)(ws + WS_Z))[(size_t)(MP + m) * INC + n] = (bf16)(cvt_pk_bf16(v, 0.f) & 0xffffu); }
        __syncthreads();
    }
#undef SKS_LOAD
#undef SKS_N0
}

constexpr int N_PHASES = 12;
__global__ void __launch_bounds__(512, 2) hawk_fwd(Args a) {
    extern __shared__ __attribute__((aligned(16))) unsigned char lds[];
    LAS unsigned char* L = (LAS unsigned char*)lds;
    const int wave = __builtin_amdgcn_readfirstlane((int)threadIdx.x >> 6), G = gridDim.x;
    volatile LAS unsigned* MISC = (volatile LAS unsigned*)(L + LDS_MISC);
    if (threadIdx.x < 64) MISC[threadIdx.x] = 0u;
#define lane lane_id()
#define tid (wave * 64 + lane_id())
    __syncthreads();
    unsigned char* ws = a.ws;
    const bool multi = (a.ph_hi - a.ph_lo) > 1;
    XcdBarrier bar; bar.bar = (unsigned*)(ws + WS_CTL) + CW_BAR + a.bar_region * XCD_BAR_WORDS; bar.x = 0; bar.st = MISC + 8;
    if (multi) bar = xcd_barrier_post((unsigned*)(ws + WS_CTL) + CW_BAR + a.bar_region * XCD_BAR_WORDS, MISC + 8);
    const int lo = a.ph_lo, hi = a.ph_hi;
#ifndef PHASE_MASK
#define PHASE_MASK 0xFFFF
#endif
#define IN(k) ((((PHASE_MASK) >> (k)) & 1) && lo <= (k) && (k) < hi)
#define SEAM(k) do { if (IN(k) && IN((k) + 1)) xcd_barrier(bar); } while (0)
#ifndef PROBE_DOUBLE
#define PROBE_DOUBLE 0
#endif
#define REP(k)
    const int gw = blockIdx.x * 8 + wave, NGW = G * 8;

    if (IN(0)) REP(0) { p0_prologue(a, L, tid, lane, wave, G); }
    if (IN(1)) REP(1) { p0b_prologue(a, L, tid, lane, wave, G); }
    SEAM(1);
    if (IN(2)) REP(2) {
        { pg8::Gemm g{(const bf16*)(ws + WS_XN8), (const bf16*)(ws + WS_WIN8), MP, INC, DM / 2}; pg8::SchedZ8 S; S.init(MP, 16384, G, (int)blockIdx.x);
          pg8::EpiQ8<true> E{(bf16*)(ws + WS_Z), INC, (const float*)(ws + WS_SA), (const float*)(ws + WS_SW8), ws + WS_G8}; pg8::gemm_phase<pg8::EpiQ8<true>, pg8::SchedZ8, true, true>(L, g, S, E); }
        const int sh = (G == 256) ? 96 : (2496 % G), cb = (int)((blockIdx.x + G - sh) % G);
        { pg8::Gemm g{(const bf16*)(ws + WS_XN), (const bf16*)(ws + WS_WINB), MP, 4608, DM}; pg8::SchedZB S; S.init(MP, 4608, G, cb);
          pg8::EpiZ E{(bf16*)(ws + WS_Z), INC}; pg8::gemm_phase<pg8::EpiZ, pg8::SchedZB, true, true>(L, g, S, E); }
        { pg8::Gemm g{(const bf16*)(ws + WS_MEMN), (const bf16*)(ws + WS_WMKV), 1024, 2048, DM}; pg8::StaticOrder S; S.init(1024, 2048, G, (int)((cb + G - (128 % G)) % G));
          pg8::EpiF32P E{(float*)(ws + WS_MKVRAW), 2048}; pg8::gemm_phase<pg8::EpiF32P, pg8::StaticOrder, true, true>(L, g, S, E); }
        {
            const int c0 = (int)blockIdx.x, cs = G, ce = 1312;
            for (int cg = c0; cg < ce; cg += cs) {
                if (cg < 288) skinny16<1, false>(ws + WS_XN + (size_t)MP * DM * 2, DM * 2, ws + WS_WINB, DM * 2, 16 * cg, DM / 32, 0, 0, (LAS float*)L, wave,
                    [&](int m, int n, float p0, float, float) { const int t = n >> 8, pno = t < 6 ? t : t + 12; ((bf16*)(ws + WS_Z))[(size_t)(MP + m) * INC + 256 * pno + (n & 255)] = (bf16)(cvt_pk_bf16(p0, 0.f) & 0xffffu); });
                else { p1_skinny_i8_stream(a, (LAS float*)L, wave, cg - 288, cs); break; }
            }
        }
    }
    SEAM(2);
    if (IN(3)) REP(3) { p2a_phase(a, L, tid, lane, wave, G); }
    SEAM(3);
    if (IN(4)) REP(4) { p2b_phase(a, L, tid, lane, wave, G); }
    SEAM(4);
    if (IN(5)) REP(5) { for (int m = gw; m < MREAL; m += NGW) combine_row(a, m, lane); }
    SEAM(5);
    if (IN(6)) REP(6) {
        auto sk = [&]() { for (int cg = blockIdx.x; cg < DM / 16; cg += G)
            skinny16<3, false>(ws + WS_YCAT + (size_t)MP * KCAT * 2, KCAT * 2, ws + WS_WCAT, KCAT * 2, 16 * cg, KCAT / 32, 48, 64, (LAS float*)L, wave,
                [&](int m, int n, float p0, float p1, float p2) { const unsigned char* zg = ws + WS_G8 + (size_t)(MP + m) * 12288 + n;
                    const float v = ((float)zg[0] * p0 + (float)zg[DM] * p1 + (float)zg[2 * DM] * p2) * (1.0f / 255.0f); ((bf16*)(ws + WS_MERGED))[(size_t)(MP + m) * DM + n] = (bf16)(cvt_pk_bf16(v, 0.f) & 0xffffu); }); };
        if (blockIdx.x & 1) sk();
        pg8::Gemm g{(const bf16*)(ws + WS_YCAT), (const bf16*)(ws + WS_WCAT), MP, DM, KCAT}; pg8::StaticOrder S; S.init(MP, DM, G, (int)blockIdx.x);
        pg8::EpiMerged E{24, 32, ws + WS_G8, 12288, (bf16*)(ws + WS_MERGED), DM}; pg8::gemm_phase<pg8::EpiMerged, pg8::StaticOrder, true, true>(L, g, S, E);
        if (!(blockIdx.x & 1)) sk();
    }
    SEAM(6);
    if (IN(7)) REP(7) {
        auto sk = [&]() { for (int cg = blockIdx.x; cg < DM / 16; cg += G)
            skinny16<1, false>(ws + WS_MERGED + (size_t)MP * DM * 2, DM * 2, ws + WS_WOUT, DM * 2, 16 * cg, DM / 32, 0, 0, (LAS float*)L, wave,
                [&](int m, int n, float p0, float, float) { ((bf16*)(ws + WS_XN))[(size_t)(MP + m) * DM + n] = (bf16)(cvt_pk_bf16(a.in[I_XS][(size_t)m * DM + n] + p0, 0.f) & 0xffffu); }); };
        if (blockIdx.x & 1) sk();
        pg8::Gemm g{(const bf16*)(ws + WS_MERGED), (const bf16*)(ws + WS_WOUT), MP, DM, DM}; pg8::StaticOrder S; S.init(MP, DM, G, (int)blockIdx.x);
        pg8::EpiOut E{a.in[I_XP], (bf16*)(ws + WS_XN), DM}; pg8::gemm_phase<pg8::EpiOut, pg8::StaticOrder, true, true>(L, g, S, E);
        if (!(blockIdx.x & 1)) sk();
    }
    SEAM(7);
    if (IN(8)) REP(8) {
        for (int m = gw; m < MREAL; m += NGW) rms_row_q8_from_bf16((const bf16*)(ws + WS_XN) + (size_t)m * DM, a.in[I_N2G], lane, (unsigned*)(ws + WS_H2Q) + (size_t)m * (DM / 4), (float*)(ws + WS_SH) + m);
        for (int m = MP + (NGW - 1 - gw); m < MREAL; m += NGW) {
            const u32x2* xr2 = (const u32x2*)((const bf16*)(ws + WS_XN) + (size_t)m * DM) + lane; f32x4* y4 = (f32x4*)x2_row(a, m) + lane;
#pragma unroll
            for (int j = 0; j < 16; ++j) { const u32x2 w = xr2[64 * j]; y4[64 * j] = (f32x4){bflo(w.x), bfhi(w.x), bflo(w.y), bfhi(w.y)}; }
        }
    }
    SEAM(8);
    if (IN(9)) REP(9) {
        pg8::Gemm g{(const bf16*)(ws + WS_H2Q), (const bf16*)(ws + WS_WQ8), MP, PQW, DM / 2}; pg8::StaticOrder S; S.init(MP, PQW, G, (int)blockIdx.x);
        pg8::EpiQ8<false> E{(bf16*)(ws + WS_QN), PQW, (const float*)(ws + WS_SH), (const float*)(ws + WS_SWQ), nullptr}; pg8::gemm_phase<pg8::EpiQ8<false>, pg8::StaticOrder, true, true>(L, g, S, E);
        for (int cg = blockIdx.x; cg < PQW / 16; cg += G)
            skinny16<1, true>(ws + WS_H2Q + (size_t)MP * DM, DM, ws + WS_WQ8, DM, 16 * cg, DM / 64, 0, 0, (LAS float*)L, wave,
                [&](int m, int n, float p0, float, float) { ((bf16*)(ws + WS_QN))[(size_t)(MP + m) * PQW + n] = (bf16)(cvt_pk_bf16(p0 * ((const float*)(ws + WS_SH))[MP + m] * ((const float*)(ws + WS_SWQ))[n], 0.f) & 0xffffu); });
    }
    SEAM(9);
    if (IN(10)) REP(10) { for (int it = blockIdx.x; it < 64 * 8; it += G) topk_item(a, L, tid, lane, wave, it); }
    SEAM(10);
    if (IN(11)) REP(11) { peer_gather_phase(a, L, wave, G); }
#undef IN
#undef SEAM
#undef lane
#undef tid
}

#ifndef MK_LAUNCH_PER_PHASE
#define MK_LAUNCH_PER_PHASE 0
#endif
extern "C" void kernel_launch(void* const* d_in, const int* in_sizes, int n_in, void* d_out, int out_size, void* d_ws, size_t ws_size, hipStream_t stream) {
    static int grid = 0;
    if (!grid) {
        if (n_in != N_IN || (size_t)out_size != OUT_END || ws_size < WS_END) { fprintf(stderr, "kernel_launch: unexpected shapes: n_in %d out %d ws %zu (need %zu)\n", n_in, out_size, ws_size, (size_t)WS_END); grid = -1; return; }
        int dev = 0, cus = 0, per_cu = 0;
        if (hipGetDevice(&dev) != hipSuccess || hipDeviceGetAttribute(&cus, hipDeviceAttributeMultiprocessorCount, dev) != hipSuccess) { grid = -1; return; }
        if (hipFuncSetAttribute((const void*)hawk_fwd, hipFuncAttributeMaxDynamicSharedMemorySize, LDS_BYTES) != hipSuccess) { fprintf(stderr, "kernel_launch: hipFuncSetAttribute failed\n"); grid = -1; return; }
        if (hipOccupancyMaxActiveBlocksPerMultiprocessor(&per_cu, (const void*)hawk_fwd, 512, LDS_BYTES) != hipSuccess || per_cu < 1) { fprintf(stderr, "kernel_launch: occupancy query says %d\n", per_cu); }
        grid = cus;
    }
    if (grid <= 0) return;
    if (hipMemsetAsync((char*)d_ws + WS_CTL, 0, CTL_BYTES, stream) != hipSuccess) return;
    Args a{};
    for (int i = 0; i < N_IN; ++i) a.in[i] = (const float*)d_in[i];
    a.out = (float*)d_out; a.ws = (unsigned char*)d_ws; a.pad = 0;
#if MK_LAUNCH_PER_PHASE
    for (int p = 0; p < N_PHASES; ++p) { a.ph_lo = p; a.ph_hi = p + 1; a.bar_region = 0; hipLaunchKernelGGL(hawk_fwd, dim3(grid), dim3(512), LDS_BYTES, stream, a); }
#elif defined(PROBE_PHASE)
    a.ph_lo = 0; a.ph_hi = PROBE_PHASE + 1; a.bar_region = 0; hipLaunchKernelGGL(hawk_fwd, dim3(grid), dim3(512), LDS_BYTES, stream, a);
    a.ph_lo = PROBE_PHASE; a.ph_hi = PROBE_PHASE + 1; a.bar_region = 1; hipLaunchKernelGGL(hawk_fwd, dim3(grid), dim3(512), LDS_BYTES, stream, a);
    if (PROBE_PHASE + 1 < N_PHASES) { a.ph_lo = PROBE_PHASE + 1; a.ph_hi = N_PHASES; a.bar_region = 2; hipLaunchKernelGGL(hawk_fwd, dim3(grid), dim3(512), LDS_BYTES, stream, a); }
#else
    a.ph_lo = 0; a.ph_hi = N_PHASES; a.bar_region = 0;
    hipLaunchKernelGGL(hawk_fwd, dim3(grid), dim3(512), LDS_BYTES, stream, a);
#endif
}
```

```cpp
#include <hip/hip_runtime.h>
#include <cstdio>
#include <cstdint>

#define GAS __attribute__((address_space(1)))
#define LAS __attribute__((address_space(3)))
typedef unsigned short bf16;
typedef short bf16x8 __attribute__((ext_vector_type(8)));
typedef float f32x4 __attribute__((ext_vector_type(4)));
typedef float f32x2 __attribute__((ext_vector_type(2)));
typedef unsigned u32x4 __attribute__((ext_vector_type(4)));
typedef unsigned u32x2 __attribute__((ext_vector_type(2)));

constexpr int DM = 4096, NBATCH = 4, SEQ = 2048, MP = NBATCH * SEQ, MS = 32, MREAL = MP + MS, MALL = 8448;
constexpr int LRUW = 1536, NLB = 12, HD = 128, NDH = 12, DILW = NDH * HD, MEMT = 256, MEMH = 4, MEMD = 256, MEMW = 1024;
constexpr int O_LX = 0, O_LG = 1536, O_Q = 3072, O_K = 4608, O_V = 6144, O_MQ = 7680, O_GATE = 8704, INC = 20992;
constexpr int KCAT = 3072;
constexpr int PH = 8, PNK = 128, PTOP = 16, PNE = 16384, PQW = 2048;
constexpr float EPS = 1e-6f;

__device__ __forceinline__ float bf2f(unsigned v) { return __uint_as_float(v << 16); }
__device__ __forceinline__ float bflo(unsigned w) { return __uint_as_float(w << 16); }
__device__ __forceinline__ float bfhi(unsigned w) { return __uint_as_float(w & 0xffff0000u); }
__device__ __forceinline__ unsigned cvt_pk_bf16(float lo, float hi) { unsigned r; asm volatile("v_cvt_pk_bf16_f32 %0, %1, %2" : "=v"(r) : "v"(lo), "v"(hi)); return r; }
__device__ __forceinline__ float wave_sum(float v) {
#pragma unroll
    for (int o = 1; o < 64; o <<= 1) v += __shfl_xor(v, o);
    return v;
}
__device__ __forceinline__ float wave_max(float v) {
#pragma unroll
    for (int o = 1; o < 64; o <<= 1) v = fmaxf(v, __shfl_xor(v, o));
    return v;
}
__device__ __forceinline__ float fast_exp(float x) { return __builtin_amdgcn_exp2f(x * 1.44269504089f); }
__device__ __forceinline__ float sigmoidf_(float x) { return __builtin_amdgcn_rcpf(1.0f + fast_exp(-x)); }
__device__ __forceinline__ float gelu_tanh(float x) { const float u = 0.7978845608f * (x + 0.044715f * x * x * x); return x * sigmoidf_(2.0f * u); }
__device__ __forceinline__ int launder(int x) { asm volatile("" : "+v"(x)); return x; }
__device__ __forceinline__ int lane_id() { return (int)__builtin_amdgcn_mbcnt_hi(~0u, __builtin_amdgcn_mbcnt_lo(~0u, 0u)); }
#define LDS_WAIT() asm volatile("s_waitcnt lgkmcnt(0)" ::: "memory")
#define VM_WAIT() asm volatile("s_waitcnt vmcnt(0)" ::: "memory")

namespace pg8 {
#define PG8_LAS __attribute__((address_space(3)))
typedef unsigned short bf16_t;
typedef short bf16x8 __attribute__((ext_vector_type(8)));
typedef float f32x4 __attribute__((ext_vector_type(4)));
typedef unsigned u32x4 __attribute__((ext_vector_type(4)));
typedef int i32x4 __attribute__((ext_vector_type(4)));
constexpr int BM = 256, BK = 64, HALF = 128, HTB = HALF * BK * 2  , STAGE_BYTES = 8 * HTB, NXCD = 8, WGM = 8;

__host__ __device__ __forceinline__ int lds_byte(int r, int c) { const int st = (r >> 4) * 2 + (c >> 5), rr = r & 15, cc = c & 31, ob = rr * 64 + cc * 2; return st * 1024 + (ob ^ (((ob >> 9) & 1) << 5)); }
__host__ __device__ __forceinline__ void stage_rc(int b, int& R, int& C) { const int st = b / 1024, sb = b % 1024, swz = sb ^ (((sb >> 9) & 1) << 5); R = (st >> 1) * 16 + swz / 64; C = (st & 1) * 32 + (swz % 64) / 2; }
__host__ __device__ __forceinline__ int perm32(int rho) { const int n = rho >> 4, i = rho & 15; return 8 * (i >> 2) + 4 * n + (i & 3); }

struct Unit { int pm, pn; };
struct Gemm { const bf16_t* A; const bf16_t* Bt; int M, N, K; };

struct StaticOrder {
    int nM, nN, nwg, G, c;
    __host__ __device__ void init(int M, int N, int G_, int c_) { nM = M / BM; nN = N / BM; nwg = nM * nN; G = G_; c = c_; }
    __host__ __device__ bool next(int i, Unit& u) const {
        const long L = (long)i * G + c; if (L >= nwg) return false;
        int wgid = (int)L; { const int q = nwg / NXCD, r = nwg % NXCD, xcd = wgid % NXCD, off = wgid / NXCD; wgid = (xcd < r ? xcd * (q + 1) : r * (q + 1) + (xcd - r) * q) + off; }
        const int nig = WGM * nN, gid = wgid / nig, fm = gid * WGM, gsz = (nM - fm) < WGM ? (nM - fm) : WGM;
        u.pm = fm + ((wgid % nig) % gsz); u.pn = (wgid % nig) / gsz; return true;
    }
    __device__ __forceinline__ void a_ready(const Unit&) const {}
    __device__ __forceinline__ void done(const Unit&) const {}
};


struct SchedZ8 : StaticOrder {
    __host__ __device__ bool next(int i, Unit& u) const {
        long L;
        if (G == 256) { if (i < 9) L = (long)i * 256 + c; else { if (c >= 96 || i > 10) return false; L = 2304 + (i - 9) * 96 + c; } }
        else L = (long)i * G + c;
        if (L < 2048) { StaticOrder::next(i, u); u.pn = u.pn < 12 ? u.pn + 6 : u.pn + 18; return true; }
        int e = (int)(L - 2048); if (e >= 448) return false;
        if (e >= 376) { e -= 376; if (e < 64) { u.pn = 22 + (e >> 5); u.pm = e & 31; } else { u.pn = 28; u.pm = e - 64; } return true; }
        if (e < 168) { const int pp = e % 28; u.pn = e / 28; u.pm = (pp / 7) * 8 + pp % 7; return true; } e -= 168;
        if (e < 112) { const int t = e / 28, pp = e % 28; u.pn = (t < 2 ? 18 + t : 22 + t); u.pm = (pp / 7) * 8 + pp % 7; return true; } e -= 112;
        { const int t = e / 24, pp = e % 24; u.pn = (t < 2 ? 20 + t : 24 + t); u.pm = (pp / 6) * 8 + pp % 6; return true; }
    }
};
struct SchedZB : StaticOrder {
    __host__ __device__ bool next(int i, Unit& u) const {
        const long L = (long)i * G + c; if (L >= 128) return false;
        int e = (int)L;
        if (e < 56) { if (e < 24) { u.pn = 28 - 12; u.pm = 8 + e; } else { u.pn = 29 - 12; u.pm = e - 24; } return true; } e -= 56;
        if (e < 32) { const int t = e >> 3, pp = e & 7; u.pn = (t < 2 ? 20 + t : 24 + t) - 12; u.pm = (pp >> 1) * 8 + 6 + (pp & 1); return true; } e -= 32;
        if (e < 16) { const int t = e >> 2; u.pn = (t < 2 ? 18 + t : 22 + t) - 12; u.pm = (e & 3) * 8 + 7; return true; } e -= 16;
        { u.pn = e >> 2; u.pm = (e & 3) * 8 + 7; return true; }
    }
};
__device__ __forceinline__ unsigned pk_bf16(float lo, float hi) { unsigned r; asm volatile("v_cvt_pk_bf16_f32 %0, %1, %2" : "=v"(r) : "v"(lo), "v"(hi)); return r; }
__device__ __forceinline__ float sigm(float x) { return __builtin_amdgcn_rcpf(1.0f + __builtin_amdgcn_exp2f(x * -1.44269504089f)); }

struct EpiZ {
    static constexpr bool PERM = true, AFTER_DRAIN = false, HOOK = false, I8 = false; typedef f32x4 acc_t;
    bf16_t* O; int ldc;
    __device__ __forceinline__ void hook(f32x4 (&)[2][2][4][2], const Unit&, int, int, int, int, int) const {}
    __device__ __forceinline__ void operator()(f32x4 (&acc)[2][2][4][2], const Unit& u, int wr, int wc, int fr, int fq) const {
        { asm volatile("" : "+v"(fr), "+v"(fq)); } const int pno = u.pn < 6 ? u.pn : u.pn + 12; const int row0 = u.pm * BM + wr * 64 + fr, col0 = pno * BM + wc * 32 + 8 * fq;
#pragma unroll
        for (int ai = 0; ai < 2; ++ai)
#pragma unroll
            for (int m = 0; m < 4; ++m) { bf16_t* rowp = O + (size_t)(row0 + ai * HALF + m * 16) * ldc + col0;
#pragma unroll
                for (int bj = 0; bj < 2; ++bj) { const f32x4 v0 = acc[ai][bj][m][0], v1 = acc[ai][bj][m][1];
                    u32x4 w; w.x = pk_bf16(v0[0], v0[1]); w.y = pk_bf16(v0[2], v0[3]); w.z = pk_bf16(v1[0], v1[1]); w.w = pk_bf16(v1[2], v1[3]);
                    *(u32x4*)(rowp + bj * HALF) = w; } }
    }
};
template <bool ZMAP> struct EpiQ8 {
    static constexpr bool PERM = true, AFTER_DRAIN = false, HOOK = false, I8 = true; typedef i32x4 acc_t;
    bf16_t* O; int ldc; const float* SA; const float* SW; unsigned char* G8;
    __device__ __forceinline__ void hook(i32x4 (&)[2][2][4][2], const Unit&, int, int, int, int, int) const {}
    static __device__ __forceinline__ unsigned gq(float v) { return (unsigned)(int)(__builtin_rintf(sigm(v) * 254.0f)) + 1u; }
    __device__ __forceinline__ void operator()(i32x4 (&acc)[2][2][4][2], const Unit& u, int wr, int wc, int fr, int fq) const {
        { asm volatile("" : "+v"(fr), "+v"(fq)); } const int pno = u.pn; const bool sg = ZMAP && pno >= 34;
        const int row0 = u.pm * BM + wr * 64 + fr, col0 = pno * BM + wc * 32 + 8 * fq, ccol0 = u.pn * BM + wc * 32 + 8 * fq;
        f32x4 sw[2][2];
#pragma unroll
        for (int bj = 0; bj < 2; ++bj) { sw[bj][0] = *(const f32x4*)(SW + ccol0 + bj * HALF); sw[bj][1] = *(const f32x4*)(SW + ccol0 + bj * HALF + 4); }
#pragma unroll
        for (int ai = 0; ai < 2; ++ai)
#pragma unroll
            for (int m = 0; m < 4; ++m) { const int r = row0 + ai * HALF + m * 16; const float sa = SA[r]; bf16_t* rowp = O + (size_t)r * ldc + col0;
#pragma unroll
                for (int bj = 0; bj < 2; ++bj) { f32x4 v0, v1;
#pragma unroll
                    for (int j = 0; j < 4; ++j) { v0[j] = (float)acc[ai][bj][m][0][j] * sa * sw[bj][0][j]; v1[j] = (float)acc[ai][bj][m][1][j] * sa * sw[bj][1][j]; }
                    if (sg) { typedef unsigned u32x2_t __attribute__((ext_vector_type(2))); u32x2_t w;
                        w.x = gq(v0[0]) | (gq(v0[1]) << 8) | (gq(v0[2]) << 16) | (gq(v0[3]) << 24); w.y = gq(v1[0]) | (gq(v1[1]) << 8) | (gq(v1[2]) << 16) | (gq(v1[3]) << 24);
                        *(u32x2_t*)(G8 + (size_t)r * 12288 + (col0 - 8704) + bj * HALF) = w; }
                    else { u32x4 w; w.x = pk_bf16(v0[0], v0[1]); w.y = pk_bf16(v0[2], v0[3]); w.z = pk_bf16(v1[0], v1[1]); w.w = pk_bf16(v1[2], v1[3]);
                        *(u32x4*)(rowp + bj * HALF) = w; } } }
    }
};
struct EpiF32P {
    static constexpr bool PERM = false, AFTER_DRAIN = false, HOOK = false, I8 = false; typedef f32x4 acc_t;
    float* C; int ldc;
    __device__ __forceinline__ void hook(f32x4 (&)[2][2][4][2], const Unit&, int, int, int, int, int) const {}
    __device__ __forceinline__ void operator()(f32x4 (&acc)[2][2][4][2], const Unit& u, int wr, int wc, int fr, int fq) const {
        { asm volatile("" : "+v"(fr), "+v"(fq)); } const int row0 = u.pm * BM + wr * 64 + fr, col0 = u.pn * BM + wc * 32 + 4 * fq;
#pragma unroll
        for (int ai = 0; ai < 2; ++ai)
#pragma unroll
            for (int m = 0; m < 4; ++m) { float* rowp = C + (size_t)(row0 + ai * HALF + m * 16) * ldc + col0;
#pragma unroll
                for (int bj = 0; bj < 2; ++bj)
#pragma unroll
                    for (int n = 0; n < 2; ++n) *(f32x4*)(rowp + bj * HALF + n * 16) = acc[ai][bj][m][n]; }
    }
};
struct EpiMerged {
    static constexpr bool PERM = true, AFTER_DRAIN = false, HOOK = true, I8 = false; typedef f32x4 acc_t;
    int hk0, hk1; const unsigned char* G; int ldg; bf16_t* O; int ldo;
    static __device__ __forceinline__ f32x4 ub4(unsigned w) { return (f32x4){(float)(w & 255u), (float)((w >> 8) & 255u), (float)((w >> 16) & 255u), (float)(w >> 24)}; }
    template <bool RATIO> __device__ __forceinline__ void scale(f32x4 (&acc)[2][2][4][2], const Unit& u, int wr, int wc, int fr, int fq, int gate) const {
        typedef unsigned u32x2_t __attribute__((ext_vector_type(2)));
        { asm volatile("" : "+v"(fr), "+v"(fq)); } const unsigned char* gb = G + gate * 4096 + u.pn * BM + wc * 32 + 8 * fq; const int row0 = u.pm * BM + wr * 64 + fr;
#pragma unroll
        for (int ai = 0; ai < 2; ++ai) {
            u32x2_t gv[4][2], gd[4][2];
#pragma unroll
            for (int m = 0; m < 4; ++m)
#pragma unroll
                for (int bj = 0; bj < 2; ++bj) { const unsigned char* gp = gb + (size_t)(row0 + ai * HALF + m * 16) * ldg + bj * HALF; gv[m][bj] = *(const u32x2_t*)gp; if (RATIO) gd[m][bj] = *(const u32x2_t*)(gp + 4096); }
#pragma unroll
            for (int m = 0; m < 4; ++m)
#pragma unroll
                for (int bj = 0; bj < 2; ++bj) { f32x4 f0 = ub4(gv[m][bj].x), f1 = ub4(gv[m][bj].y);
                    if (RATIO) { const f32x4 d0 = ub4(gd[m][bj].x), d1 = ub4(gd[m][bj].y);
#pragma unroll
                        for (int j = 0; j < 4; ++j) { f0[j] *= __builtin_amdgcn_rcpf(d0[j]); f1[j] *= __builtin_amdgcn_rcpf(d1[j]); } }
                    else { f0 = f0 * (1.0f / 255.0f); f1 = f1 * (1.0f / 255.0f); }
                    acc[ai][bj][m][0] *= f0; acc[ai][bj][m][1] *= f1; }
            asm volatile("" ::: "memory");
        }
    }
    __device__ __forceinline__ void hook(f32x4 (&acc)[2][2][4][2], const Unit& u, int t, int wr, int wc, int fr, int fq) const {
        const int b = (t == hk0) ? 0 : 1;
        scale<true>(acc, u, wr, wc, fr, fq, b);
    }
    __device__ __forceinline__ void operator()(f32x4 (&acc)[2][2][4][2], const Unit& u, int wr, int wc, int fr, int fq) const {
        scale<false>(acc, u, wr, wc, fr, fq, 2);
        { asm volatile("" : "+v"(fr), "+v"(fq)); } const int row0 = u.pm * BM + wr * 64 + fr, col0 = u.pn * BM + wc * 32 + 8 * fq;
#pragma unroll
        for (int ai = 0; ai < 2; ++ai)
#pragma unroll
            for (int m = 0; m < 4; ++m) { bf16_t* rowp = O + (size_t)(row0 + ai * HALF + m * 16) * ldo + col0;
#pragma unroll
                for (int bj = 0; bj < 2; ++bj) { const f32x4 v0 = acc[ai][bj][m][0], v1 = acc[ai][bj][m][1];
                    u32x4 w; w.x = pk_bf16(v0[0], v0[1]); w.y = pk_bf16(v0[2], v0[3]); w.z = pk_bf16(v1[0], v1[1]); w.w = pk_bf16(v1[2], v1[3]);
                    *(u32x4*)(rowp + bj * HALF) = w; } }
    }
};
struct EpiOut {
    static constexpr bool PERM = true, AFTER_DRAIN = false, HOOK = false, I8 = false; typedef f32x4 acc_t;
    const float* xp; bf16_t* O; int ld;
    __device__ __forceinline__ void hook(f32x4 (&)[2][2][4][2], const Unit&, int, int, int, int, int) const {}
    __device__ __forceinline__ void operator()(f32x4 (&acc)[2][2][4][2], const Unit& u, int wr, int wc, int fr, int fq) const {
        { asm volatile("" : "+v"(fr), "+v"(fq)); } const int row0 = u.pm * BM + wr * 64 + fr, col0 = u.pn * BM + wc * 32 + 8 * fq;
#pragma unroll
        for (int ai = 0; ai < 2; ++ai) {
            f32x4 xv[4][2][2];
#pragma unroll
            for (int m = 0; m < 4; ++m) { const float* src = xp + (size_t)(row0 + ai * HALF + m * 16) * ld + col0;
#pragma unroll
                for (int bj = 0; bj < 2; ++bj) { xv[m][bj][0] = *(const f32x4*)(src + bj * HALF); xv[m][bj][1] = *(const f32x4*)(src + bj * HALF + 4); } }
#pragma unroll
            for (int m = 0; m < 4; ++m) { bf16_t* dst = O + (size_t)(row0 + ai * HALF + m * 16) * ld + col0;
#pragma unroll
                for (int bj = 0; bj < 2; ++bj) { const f32x4 v0 = xv[m][bj][0] + acc[ai][bj][m][0], v1 = xv[m][bj][1] + acc[ai][bj][m][1];
                    u32x4 w; w.x = pk_bf16(v0[0], v0[1]); w.y = pk_bf16(v0[2], v0[3]); w.z = pk_bf16(v1[0], v1[1]); w.w = pk_bf16(v1[2], v1[3]);
                    *(u32x4*)(dst + bj * HALF) = w; } }
            asm volatile("" ::: "memory");
        }
    }
};
struct EpiB16 {
    static constexpr bool PERM = true, AFTER_DRAIN = false, HOOK = false, I8 = false; typedef f32x4 acc_t;
    bf16_t* O; int ldc;
    __device__ __forceinline__ void hook(f32x4 (&)[2][2][4][2], const Unit&, int, int, int, int, int) const {}
    __device__ __forceinline__ void operator()(f32x4 (&acc)[2][2][4][2], const Unit& u, int wr, int wc, int fr, int fq) const {
        { asm volatile("" : "+v"(fr), "+v"(fq)); } const int row0 = u.pm * BM + wr * 64 + fr, col0 = u.pn * BM + wc * 32 + 8 * fq;
#pragma unroll
        for (int ai = 0; ai < 2; ++ai)
#pragma unroll
            for (int m = 0; m < 4; ++m) { bf16_t* rowp = O + (size_t)(row0 + ai * HALF + m * 16) * ldc + col0;
#pragma unroll
                for (int bj = 0; bj < 2; ++bj) { const f32x4 v0 = acc[ai][bj][m][0], v1 = acc[ai][bj][m][1];
                    u32x4 w; w.x = pk_bf16(v0[0], v0[1]); w.y = pk_bf16(v0[2], v0[3]); w.z = pk_bf16(v1[0], v1[1]); w.w = pk_bf16(v1[2], v1[3]);
                    *(u32x4*)(rowp + bj * HALF) = w; } }
    }
};

template <class Epi, class Sched, bool ALIGN_EPI = false, bool SP2 = false>
__device__ __forceinline__ void gemm_phase(PG8_LAS unsigned char* lds, const Gemm g, const Sched& S, const Epi& E) {
    const int tid = threadIdx.x, wid = __builtin_amdgcn_readfirstlane(tid >> 6), lane = tid & 63, wr = wid >> 2, wc = wid & 3, fr = lane & 15, fq = lane >> 4;
    const int K = g.K, nt = K / BK;
    unsigned voffA[2], voffB[2];
#pragma unroll
    for (int i = 0; i < 2; ++i) { int R, C; stage_rc(tid * 16 + i * 8192, R, C); const int Rb = Epi::PERM ? ((R & ~31) + perm32(R & 31)) : R;
        voffA[i] = (unsigned)(R * K + C) * 2u; voffB[i] = (unsigned)(Rb * K + C) * 2u; }
    const size_t kstep = (size_t)(BK * 2);
    const size_t hstep = (size_t)HALF * K * 2;
    const size_t tstep = 2 * hstep;
    const unsigned ldsw = (unsigned)wid * 1024u;
    const int aoff = lds_byte(wr * 64 + fr, fq * 8), boff = lds_byte(wc * 32 + fr, fq * 8);
#define PG8_SA(b, h) (((b) * 2 + (h)) * HTB)
#define PG8_SB(b, h) ((4 + (b) * 2 + (h)) * HTB)
#define PG8_STAGE(bufoff, gbase, voff) do { _Pragma("unroll") for (int _i = 0; _i < 2; ++_i) \
        __builtin_amdgcn_global_load_lds((const unsigned*)((const char*)(gbase) + (voff)[_i]), (PG8_LAS unsigned*)(lds + (bufoff) + ldsw + _i * 8192), 16, 0, 0); } while (0)
#define PG8_LDA(dst, b, h) do { _Pragma("unroll") for (int m = 0; m < 4; ++m) _Pragma("unroll") for (int k = 0; k < 2; ++k) dst[m][k] = *(const PG8_LAS bf16x8*)(lds + PG8_SA(b, h) + aoff + m * 2048 + k * 1024); } while (0)
#define PG8_LDB(dst, b, h) do { _Pragma("unroll") for (int n = 0; n < 2; ++n) _Pragma("unroll") for (int k = 0; k < 2; ++k) dst[n][k] = *(const PG8_LAS bf16x8*)(lds + PG8_SB(b, h) + boff + n * 2048 + k * 1024); } while (0)
#define PG8_MMA(ai, bj, At, Bt) do { __builtin_amdgcn_s_setprio(1); _Pragma("unroll") for (int m = 0; m < 4; ++m) _Pragma("unroll") for (int n = 0; n < 2; ++n) _Pragma("unroll") for (int k = 0; k < 2; ++k) { \
        if constexpr (Epi::I8) acc[ai][bj][m][n] = __builtin_bit_cast(acc_t, __builtin_amdgcn_mfma_i32_16x16x64_i8(__builtin_bit_cast(i32x4, Bt[n][k]), __builtin_bit_cast(i32x4, At[m][k]), __builtin_bit_cast(i32x4, acc[ai][bj][m][n]), 0, 0, 0)); \
        else acc[ai][bj][m][n] = __builtin_bit_cast(acc_t, __builtin_amdgcn_mfma_f32_16x16x32_bf16(Bt[n][k], At[m][k], __builtin_bit_cast(f32x4, acc[ai][bj][m][n]), 0, 0, 0)); } __builtin_amdgcn_s_setprio(0); } while (0)
#define PG8_WAIT_V(n) asm volatile("s_waitcnt vmcnt(" #n ")" ::: "memory")
#define PG8_WAIT_L(n) asm volatile("s_waitcnt lgkmcnt(" #n ")" ::: "memory")
#define PG8_BAR __builtin_amdgcn_s_barrier()
#define PG8_SCHED __builtin_amdgcn_sched_barrier(0)
    Unit cur, nxt; int ui = 0;
    if (!S.next(0, cur)) return;
    typedef typename Epi::acc_t acc_t;
    acc_t acc[2][2][4][2];
#pragma unroll
    for (int a = 0; a < 2; ++a)
#pragma unroll
        for (int b = 0; b < 2; ++b)
#pragma unroll
            for (int m = 0; m < 4; ++m)
#pragma unroll
                for (int n = 0; n < 2; ++n) acc[a][b][m][n] = acc_t{};
    bf16x8 At[4][2], B0[2][2], B1[2][2];
    const char* cA = (const char*)g.A + (size_t)cur.pm * tstep; const char* cB = (const char*)g.Bt + (size_t)cur.pn * tstep;
    S.a_ready(cur);
    if constexpr (SP2) {
        PG8_STAGE(PG8_SB(0, 0), cB, voffB); PG8_STAGE(PG8_SB(0, 1), cB + hstep, voffB); PG8_STAGE(PG8_SA(0, 0), cA, voffA); PG8_STAGE(PG8_SA(0, 1), cA + hstep, voffA);
        if (wr == 1) PG8_BAR;
        PG8_WAIT_V(2); PG8_BAR;
        PG8_STAGE(PG8_SB(1, 0), cB + kstep, voffB); PG8_STAGE(PG8_SA(1, 0), cA + kstep, voffA); PG8_STAGE(PG8_SB(1, 1), cB + hstep + kstep, voffB);
        PG8_WAIT_V(6); PG8_BAR;
    } else {
        PG8_STAGE(PG8_SB(0, 0), cB, voffB); PG8_STAGE(PG8_SA(0, 0), cA, voffA); PG8_STAGE(PG8_SB(0, 1), cB + hstep, voffB); PG8_STAGE(PG8_SA(0, 1), cA + hstep, voffA);
        if (wr == 1) PG8_BAR;
        PG8_WAIT_V(4); PG8_BAR;
        PG8_STAGE(PG8_SB(1, 0), cB + kstep, voffB); PG8_STAGE(PG8_SA(1, 0), cA + kstep, voffA); PG8_STAGE(PG8_SB(1, 1), cB + hstep + kstep, voffB);
        PG8_WAIT_V(6); PG8_BAR;
    }
    for (;;) {
        const bool has_next = S.next(ui + 1, nxt);
        const char* nA = has_next ? (const char*)g.A + (size_t)nxt.pm * tstep : cA; const char* nB = has_next ? (const char*)g.Bt + (size_t)nxt.pn * tstep : cB;
        for (int t = 0; t < nt; t += 2) {
            const bool last = (t == nt - 2);
            const char* a1 = cA + (size_t)(t + 1) * kstep;
            const char* a2 = last ? nA : cA + (size_t)(t + 2) * kstep; const char* b2 = last ? nB : cB + (size_t)(t + 2) * kstep;
            const char* a3 = a2 + kstep; const char* b3 = b2 + kstep;
            if (last && has_next) S.a_ready(nxt);
            if constexpr (Epi::HOOK) { if (t == E.hk0 || t == E.hk1) E.hook(acc, cur, t, wr, wc, fr, fq); }
            if constexpr (SP2) {
            PG8_LDB(B0, 0, 0); PG8_LDB(B1, 0, 1); PG8_SCHED; PG8_LDA(At, 0, 0); PG8_STAGE(PG8_SA(1, 1), a1 + hstep, voffA);
            PG8_WAIT_V(8); PG8_WAIT_L(0); PG8_BAR; PG8_MMA(0, 0, At, B0); PG8_MMA(0, 1, At, B1); PG8_BAR; PG8_SCHED;
            PG8_LDA(At, 0, 1); PG8_STAGE(PG8_SB(0, 0), b2, voffB); PG8_STAGE(PG8_SB(0, 1), b2 + hstep, voffB); PG8_STAGE(PG8_SA(0, 0), a2, voffA);
            PG8_WAIT_V(8); PG8_WAIT_L(0); PG8_BAR; PG8_MMA(1, 0, At, B0); PG8_MMA(1, 1, At, B1); PG8_BAR; PG8_SCHED;
            PG8_LDB(B0, 1, 0); PG8_LDB(B1, 1, 1); PG8_SCHED; PG8_LDA(At, 1, 0); PG8_STAGE(PG8_SA(0, 1), a2 + hstep, voffA);
            PG8_WAIT_V(8); PG8_WAIT_L(0); PG8_BAR; PG8_MMA(0, 0, At, B0); PG8_MMA(0, 1, At, B1); PG8_BAR; PG8_SCHED;
            PG8_LDA(At, 1, 1); PG8_STAGE(PG8_SB(1, 0), b3, voffB); PG8_STAGE(PG8_SB(1, 1), b3 + hstep, voffB); PG8_STAGE(PG8_SA(1, 0), a3, voffA);
            PG8_WAIT_V(8); PG8_WAIT_L(0); PG8_BAR; PG8_MMA(1, 0, At, B0); PG8_MMA(1, 1, At, B1); PG8_BAR; PG8_SCHED;
            } else {
            PG8_LDB(B0, 0, 0); PG8_SCHED; PG8_LDA(At, 0, 0); PG8_STAGE(PG8_SA(1, 1), a1 + hstep, voffA);
            PG8_WAIT_L(8); PG8_BAR; PG8_WAIT_L(0); PG8_MMA(0, 0, At, B0); PG8_BAR; PG8_SCHED;
            PG8_LDB(B1, 0, 1); PG8_STAGE(PG8_SB(0, 0), b2, voffB);
            PG8_BAR; PG8_WAIT_L(0); PG8_MMA(0, 1, At, B1); PG8_BAR;
            PG8_LDA(At, 0, 1); PG8_STAGE(PG8_SA(0, 0), a2, voffA);
            PG8_BAR; PG8_WAIT_L(0); PG8_MMA(1, 0, At, B0); PG8_BAR; PG8_SCHED;
            PG8_STAGE(PG8_SB(0, 1), b2 + hstep, voffB);
            PG8_WAIT_V(6); PG8_BAR; PG8_MMA(1, 1, At, B1); PG8_BAR;
            PG8_LDB(B0, 1, 0); PG8_SCHED; PG8_LDA(At, 1, 0); PG8_STAGE(PG8_SA(0, 1), a2 + hstep, voffA);
            PG8_WAIT_L(8); PG8_BAR; PG8_WAIT_L(0); PG8_MMA(0, 0, At, B0); PG8_BAR; PG8_SCHED;
            PG8_LDB(B1, 1, 1); PG8_STAGE(PG8_SB(1, 0), b3, voffB);
            PG8_BAR; PG8_WAIT_L(0); PG8_MMA(0, 1, At, B1); PG8_BAR;
            PG8_LDA(At, 1, 1); PG8_STAGE(PG8_SA(1, 0), a3, voffA);
            PG8_BAR; PG8_WAIT_L(0); PG8_MMA(1, 0, At, B0); PG8_BAR; PG8_SCHED;
            PG8_STAGE(PG8_SB(1, 1), b3 + hstep, voffB);
            PG8_WAIT_V(6); PG8_BAR; PG8_MMA(1, 1, At, B1); PG8_BAR;
            }
        }
        if constexpr (ALIGN_EPI) { if (wr == 0) PG8_BAR; }
        if constexpr (!Epi::AFTER_DRAIN) { E(acc, cur, wr, wc, fr, fq); S.done(cur); }
        if (!has_next) break;
#pragma unroll
        for (int a = 0; a < 2; ++a)
#pragma unroll
            for (int b = 0; b < 2; ++b)
#pragma unroll
                for (int m = 0; m < 4; ++m)
#pragma unroll
                    for (int n = 0; n < 2; ++n) acc[a][b][m][n] = acc_t{};
        cur = nxt; cA = nA; cB = nB; ++ui;
        if constexpr (ALIGN_EPI) { if (wr == 1) PG8_BAR; }
    }
    PG8_WAIT_V(0);
    if constexpr (!ALIGN_EPI) { if (wr == 0) PG8_BAR; }
    PG8_BAR;
    if constexpr (Epi::AFTER_DRAIN) { E.fused(acc, cur, wr, wc, fr, fq, lds, wid, lane); S.done(cur); }
#undef PG8_SA
#undef PG8_SB
#undef PG8_STAGE
#undef PG8_LDA
#undef PG8_LDB
#undef PG8_MMA
#undef PG8_WAIT_V
#undef PG8_WAIT_L
#undef PG8_BAR
#undef PG8_SCHED
}
}

constexpr size_t CTL_BYTES = 1u << 20;
constexpr size_t WS_CTL = 0;
constexpr size_t WS_WIN = CTL_BYTES;
constexpr size_t WS_WMKV = WS_WIN + (size_t)INC * DM * 2;
constexpr size_t WS_WCAT = WS_WMKV + (size_t)2048 * DM * 2;
constexpr size_t WS_WOUT = WS_WCAT + (size_t)DM * KCAT * 2;
constexpr size_t WS_WQ = WS_WOUT + (size_t)DM * DM * 2;
constexpr size_t WS_LRUW = WS_WQ + (size_t)PQW * DM * 2;
constexpr size_t WS_SUBK = WS_LRUW + (size_t)24 * 128 * 128 * 2;
constexpr size_t WS_U = WS_SUBK + (size_t)8 * 2 * 128 * 128 * 2;
constexpr size_t WS_V = WS_U + (size_t)PNE * DM * 2;
constexpr size_t WS_XN = WS_V + (size_t)PNE * DM * 2;
constexpr size_t WS_MEMN = WS_XN + (size_t)MALL * DM * 2;
constexpr size_t WS_Z = WS_MEMN + (size_t)1024 * DM * 2;
constexpr size_t WS_QN = WS_Z + (size_t)MALL * INC * 2;
constexpr size_t WS_KN = WS_QN + (size_t)MALL * DILW * 2;
constexpr size_t WS_MQN = WS_KN + (size_t)MALL * DILW * 2;
constexpr size_t WS_MK = WS_MQN + (size_t)MALL * MEMW * 2;
constexpr size_t WS_MV = WS_MK + (size_t)1024 * 1024 * 2;
constexpr size_t WS_HLOC = WS_MV + (size_t)1024 * 1024 * 2;
constexpr size_t WS_PCUM = WS_HLOC + (size_t)MP * LRUW * 4;
constexpr size_t WS_AGG = WS_PCUM + (size_t)MP * LRUW * 4;
constexpr size_t WS_OG = WS_AGG + (size_t)4 * 16 * 1536 * 2 * 4;
constexpr size_t WS_LSE = WS_OG + (size_t)3 * MALL * 512 * 4;
constexpr size_t WS_YCAT = WS_LSE + (size_t)3 * MALL * 4 * 4;
constexpr size_t WS_MERGED = WS_YCAT + (size_t)MALL * KCAT * 2;
constexpr size_t WS_PID = WS_MERGED + (size_t)MALL * DM * 2;
constexpr size_t WS_PW = WS_PID + (size_t)MALL * 128 * 4;
constexpr size_t WS_BIAS = WS_PW + (size_t)MALL * 128 * 4;
constexpr size_t WS_SPLUS = WS_BIAS + 8192;
constexpr size_t WS_MKVRAW = WS_SPLUS + 8192;
constexpr size_t WS_G8 = WS_MKVRAW + (size_t)1024 * 2048 * 4;
constexpr size_t WS_END = WS_G8 + (size_t)MALL * 12288;
constexpr size_t WS_WINB = WS_WIN, WS_WIN8 = WS_WIN + (40u << 20), WS_SW8 = WS_WIN + (123u << 20), WS_XN8 = WS_WIN + (124u << 20), WS_SA = WS_WIN + (158u << 20);
static_assert(WS_SA + (size_t)MALL * 4 <= WS_WMKV && WS_XN8 + (size_t)MALL * DM <= WS_SA && WS_WIN8 + (size_t)INC * DM <= WS_SW8 && WS_SW8 + (size_t)INC * 4 <= WS_XN8, "int8 layout");
constexpr size_t WS_WQ8 = WS_WQ, WS_SWQ = WS_WQ + (8u << 20);
constexpr int CW_CM = 32768, CW_CMQ = CW_CM + INC;
constexpr size_t WS_SU = WS_U + (64u << 20), WS_SV = WS_V + (64u << 20), WS_H2Q = WS_U + (66u << 20), WS_SH = WS_U + (100u << 20);
static_assert(WS_H2Q + (size_t)MALL * DM <= WS_SH && WS_SH + (size_t)MALL * 4 <= WS_V, "quantized layout");
static_assert((size_t)MALL * PQW * 2 <= 2 * (size_t)MALL * DILW * 2, "Q2 overlay");

constexpr size_t OUT_YP = 0;
constexpr size_t OUT_YS = OUT_YP + (size_t)MP * DM;
constexpr size_t OUT_PCONV = OUT_YS + (size_t)MS * DM;
constexpr size_t OUT_PRNN = OUT_PCONV + (size_t)NBATCH * 3 * LRUW;
constexpr size_t OUT_PSWA0 = OUT_PRNN + (size_t)NBATCH * LRUW;
constexpr size_t OUT_PSWA1 = OUT_PSWA0 + (size_t)NBATCH * 128 * 1024;
constexpr size_t OUT_PSWA2 = OUT_PSWA1 + (size_t)NBATCH * 512 * 1024;
constexpr size_t OUT_PMEM = OUT_PSWA2 + (size_t)NBATCH * 2048 * 1024;
constexpr size_t OUT_SCONV = OUT_PMEM + (size_t)NBATCH * 256 * 2048;
constexpr size_t OUT_SRNN = OUT_SCONV + (size_t)MS * 3 * LRUW;
constexpr size_t OUT_SSWA0 = OUT_SRNN + (size_t)MS * LRUW;
constexpr size_t OUT_SSWA1 = OUT_SSWA0 + (size_t)MS * 128 * 1024;
constexpr size_t OUT_SSWA2 = OUT_SSWA1 + (size_t)MS * 512 * 1024;
constexpr size_t OUT_END = OUT_SSWA2 + (size_t)MS * 2048 * 1024;
static_assert(OUT_END == 135094272, "output size");

constexpr int CW_BAR = 4096;
constexpr int CW_CMDONE = 2048;

constexpr int LDS_BYTES = 163840;
constexpr int LDS_MISC = LDS_BYTES - 256;

enum { I_XP = 0, I_XS, I_SCONV, I_SRNN, I_C0, I_C1, I_C2, I_CMEM, I_MEMP, I_RELB, I_N1G, I_WIN, I_CONVW, I_CONVB, I_LWA, I_LBA, I_LWI, I_LBI, I_LAM, I_QNG, I_KNG, I_MNG, I_WMKV, I_MQNG, I_MKNG,
       I_WBA, I_WBB, I_WBM, I_WOUT, I_N2G, I_PWQ, I_PSUB, I_PU, I_PV, N_IN };

#define XB_TMO      128
#define XB_XCNT(j)  (256  + 64 * (j))
#define XB_XSUB(j)  (1280 + 64 * (j))
#define XB_XGEN(j)  (2304 + 64 * (j))
#define XB_TOP      3328
#define XB_TOPGEN   3392
#define XCD_BAR_WORDS 3456
#define XB_SPIN_CAP (1u << 18)

__device__ __forceinline__ unsigned xb_ld(unsigned* p)              { return __hip_atomic_load(p, __ATOMIC_RELAXED, __HIP_MEMORY_SCOPE_AGENT); }
__device__ __forceinline__ unsigned xb_add(unsigned* p, unsigned v) { return __hip_atomic_fetch_add(p, v, __ATOMIC_RELAXED, __HIP_MEMORY_SCOPE_AGENT); }
__device__ __forceinline__ unsigned xb_xcc_id() { return (unsigned)__builtin_amdgcn_s_getreg((3 << 11) | 20) & 0xFu; }
#define XB_SPIN(cond, bar) do { unsigned _sp = 0; while (cond) { __builtin_amdgcn_s_sleep(1); \
    if ((++_sp & 255u) == 0u) { if (xb_ld(&(bar)[XB_TMO])) break; if (_sp > XB_SPIN_CAP) { atomicAdd(&(bar)[XB_TMO], 1u); break; } } } } while (0)

struct XcdBarrier {
    unsigned* bar; unsigned x;
    volatile LAS unsigned* st;
};
__device__ __forceinline__ XcdBarrier xcd_barrier_post(unsigned* bar, volatile LAS unsigned* st) {
    XcdBarrier b; b.bar = bar; b.x = xb_xcc_id(); b.st = st;
    if (threadIdx.x == 0) (void)xb_add(&bar[XB_XCNT(b.x)], 1u);
    return b;
}
__device__ __forceinline__ void xcd_barrier_complete(unsigned* bar, unsigned x, unsigned& nloc, unsigned& nx) {
    const unsigned G = gridDim.x * gridDim.y * gridDim.z;
    unsigned sum, cnt, mine, sp = 0u;
    for (;;) {
        sum = 0u; cnt = 0u; mine = 0u;
#pragma unroll
        for (unsigned j = 0; j < 16; ++j) { const unsigned c = xb_ld(&bar[XB_XCNT(j)]); sum += c; cnt += (c > 0u) ? 1u : 0u; mine = (j == x) ? c : mine; }
        if (sum == G) break;
        __builtin_amdgcn_s_sleep(1);
        if ((++sp & 255u) == 0u) { if (xb_ld(&bar[XB_TMO])) break; if (sp > XB_SPIN_CAP) { atomicAdd(&bar[XB_TMO], 1u); break; } }
    }
    nloc = mine > 0u ? mine : 1u; nx = cnt > 0u ? cnt : 1u;
}
__device__ __forceinline__ void xcd_barrier(const XcdBarrier& b) {
    asm volatile("s_waitcnt vmcnt(0)" ::: "memory");
    __syncthreads();
    if (threadIdx.x == 0) {
        unsigned* bar = b.bar;
        __builtin_amdgcn_s_waitcnt(0);
        unsigned nloc = b.st[0], nx = b.st[1];
        if (nloc == 0u) { xcd_barrier_complete(bar, b.x, nloc, nx); b.st[0] = nloc; b.st[1] = nx; }
        const unsigned old = xb_add(&bar[XB_XSUB(b.x)], 1u);
        const unsigned gen = old / nloc;
        if (old + 1u == (gen + 1u) * nloc) {
            __builtin_amdgcn_fence(__ATOMIC_RELEASE, "agent");
            asm volatile("s_waitcnt vmcnt(0)" ::: "memory");
            const unsigned og = xb_add(&bar[XB_TOP], 1u);
            const unsigned tg = og / nx;
            if (og + 1u == (tg + 1u) * nx) xb_add(&bar[XB_TOPGEN], 1u);
            else XB_SPIN(xb_ld(&bar[XB_TOPGEN]) == tg, bar);
            __builtin_amdgcn_fence(__ATOMIC_ACQUIRE, "agent");
            xb_add(&bar[XB_XGEN(b.x)], 1u);
            asm volatile("s_waitcnt vmcnt(0)" ::: "memory");
        } else {
            XB_SPIN(xb_ld(&bar[XB_XGEN(b.x)]) == gen, bar);
            __builtin_amdgcn_fence(__ATOMIC_ACQUIRE, "agent");
            asm volatile("s_waitcnt vmcnt(0)" ::: "memory");
        }
    }
    __syncthreads();
}

struct Args { const float* in[N_IN]; float* out; unsigned char* ws; int ph_lo, ph_hi, bar_region, pad; };

__device__ __forceinline__ void transpose_item(const float* W, int K, int N, bf16* WT, int ldt, int koff, LAS float* scr, int item, int lane) {
    const int nblk = N / 32, kb = item / nblk, nb = item % nblk, k0 = 64 * kb, n0 = 32 * nb;
#pragma unroll 8
    for (int i = 0; i < 32; ++i) { const int kk = 2 * i + (lane >> 5); scr[kk * 33 + (lane & 31)] = W[(size_t)(k0 + kk) * N + n0 + (lane & 31)]; }
    LDS_WAIT(); asm volatile("" ::: "memory");
    const int c = lane & 7;
#pragma unroll
    for (int j = 0; j < 4; ++j) { const int n = (lane >> 3) + 8 * j; const LAS float* s = scr + (8 * c) * 33 + n;
        u32x4 o; o.x = cvt_pk_bf16(s[0 * 33], s[1 * 33]); o.y = cvt_pk_bf16(s[2 * 33], s[3 * 33]); o.z = cvt_pk_bf16(s[4 * 33], s[5 * 33]); o.w = cvt_pk_bf16(s[6 * 33], s[7 * 33]);
        *(u32x4*)(WT + (size_t)(n0 + n) * ldt + koff + k0 + 8 * c) = o; }
    LDS_WAIT(); asm volatile("" ::: "memory");
}

__device__ __forceinline__ void transpose_tile(const float* W, int K, int N, bf16* WT, int ldt, int koff, LAS unsigned char* T, int item, int tid) {
    const int nblk = N / 256, kb = item / nblk, nb = item % nblk, k0 = 128 * kb, n0 = 256 * nb;
    const int c = tid & 63, rp = tid >> 6;
#pragma unroll
    for (int i = 0; i < 8; ++i) { const int r0 = 16 * i + 2 * rp;
        const f32x4 x = *(const f32x4*)(W + (size_t)(k0 + r0) * N + n0 + 4 * c), y = *(const f32x4*)(W + (size_t)(k0 + r0 + 1) * N + n0 + 4 * c);
        LAS unsigned char* d = T + (4 * c) * 264 + r0 * 2;
        *(LAS unsigned*)(d) = cvt_pk_bf16(x.x, y.x); *(LAS unsigned*)(d + 264) = cvt_pk_bf16(x.y, y.y); *(LAS unsigned*)(d + 528) = cvt_pk_bf16(x.z, y.z); *(LAS unsigned*)(d + 792) = cvt_pk_bf16(x.w, y.w); }
    __syncthreads();
    const int ch = tid & 15, nr = tid >> 4;
#pragma unroll
    for (int i = 0; i < 8; ++i) { const int n = nr + 32 * i; const LAS unsigned* sp = (const LAS unsigned*)(T + n * 264 + ch * 16);
        u32x4 o; o.x = sp[0]; o.y = sp[1]; o.z = sp[2]; o.w = sp[3];
        *(u32x4*)(WT + (size_t)(n0 + n) * ldt + koff + k0 + 8 * ch) = o; }
    __syncthreads();
}

__device__ __forceinline__ void colmax_tile(const float* W, int N, int n0, int k0, unsigned* cm, LAS float* red, int tid) {
    const int c = tid & 63, rp = tid >> 6; float mx[4] = {0.f, 0.f, 0.f, 0.f};
#pragma unroll
    for (int i = 0; i < 8; ++i) { const int r0 = 16 * i + 2 * rp;
        const f32x4 x = *(const f32x4*)(W + (size_t)(k0 + r0) * N + n0 + 4 * c), y = *(const f32x4*)(W + (size_t)(k0 + r0 + 1) * N + n0 + 4 * c);
        mx[0] = fmaxf(mx[0], fmaxf(fabsf(x.x), fabsf(y.x))); mx[1] = fmaxf(mx[1], fmaxf(fabsf(x.y), fabsf(y.y))); mx[2] = fmaxf(mx[2], fmaxf(fabsf(x.z), fabsf(y.z))); mx[3] = fmaxf(mx[3], fmaxf(fabsf(x.w), fabsf(y.w))); }
#pragma unroll
    for (int j = 0; j < 4; ++j) red[rp * 256 + 4 * c + j] = mx[j];
    __syncthreads();
    if (tid < 256) { float m = red[tid];
#pragma unroll
        for (int w = 1; w < 8; ++w) m = fmaxf(m, red[w * 256 + tid]);
        atomicMax(cm + tid, __float_as_uint(m)); }
    __syncthreads();
}
template <bool BF> __device__ __forceinline__ void transpose_tile_q8(const float* W, int N, int n0, int k0, const unsigned* cm, unsigned char* WT8, int nc0, float* sw, LAS unsigned char* T, int tid, bf16* WTB = nullptr) {
    const int c = tid & 63, rp = tid >> 6; float sc[4];
#pragma unroll
    for (int j = 0; j < 4; ++j) sc[j] = 127.0f / fmaxf(__uint_as_float(__hip_atomic_load(cm + 4 * c + j, __ATOMIC_RELAXED, __HIP_MEMORY_SCOPE_AGENT)), 1e-30f);
#pragma unroll
    for (int i = 0; i < 8; ++i) { const int r0 = 16 * i + 2 * rp;
        const f32x4 x = *(const f32x4*)(W + (size_t)(k0 + r0) * N + n0 + 4 * c), y = *(const f32x4*)(W + (size_t)(k0 + r0 + 1) * N + n0 + 4 * c);
        LAS unsigned char* d = T + (4 * c) * 144 + r0;
        *(LAS unsigned short*)(d) = (unsigned short)(((int)rintf(x.x * sc[0]) & 255) | (((int)rintf(y.x * sc[0]) & 255) << 8));
        *(LAS unsigned short*)(d + 144) = (unsigned short)(((int)rintf(x.y * sc[1]) & 255) | (((int)rintf(y.y * sc[1]) & 255) << 8));
        *(LAS unsigned short*)(d + 288) = (unsigned short)(((int)rintf(x.z * sc[2]) & 255) | (((int)rintf(y.z * sc[2]) & 255) << 8));
        *(LAS unsigned short*)(d + 432) = (unsigned short)(((int)rintf(x.w * sc[3]) & 255) | (((int)rintf(y.w * sc[3]) & 255) << 8));
        if (BF) { LAS unsigned char* e = T + 36864 + (4 * c) * 264 + r0 * 2;
            *(LAS unsigned*)(e) = cvt_pk_bf16(x.x, y.x); *(LAS unsigned*)(e + 264) = cvt_pk_bf16(x.y, y.y); *(LAS unsigned*)(e + 528) = cvt_pk_bf16(x.z, y.z); *(LAS unsigned*)(e + 792) = cvt_pk_bf16(x.w, y.w); } }
    __syncthreads();
    const int ch = tid & 7, nr = tid >> 3;
#pragma unroll
    for (int i = 0; i < 4; ++i) { const int n = nr + 64 * i; *(u32x4*)(WT8 + (size_t)(nc0 + n) * DM + k0 + 16 * ch) = *(const LAS u32x4*)(T + n * 144 + ch * 16); }
    if (BF) { const int ch2 = tid & 15, nr2 = tid >> 4;
#pragma unroll
        for (int i = 0; i < 8; ++i) { const int n = nr2 + 32 * i; const LAS unsigned* sp = (const LAS unsigned*)(T + 36864 + n * 264 + ch2 * 16);
            u32x4 o; o.x = sp[0]; o.y = sp[1]; o.z = sp[2]; o.w = sp[3];
            *(u32x4*)(WTB + (size_t)n * DM + k0 + 8 * ch2) = o; } }
    if (k0 == 0 && tid < 256) sw[nc0 + tid] = fmaxf(__uint_as_float(__hip_atomic_load(cm + tid, __ATOMIC_RELAXED, __HIP_MEMORY_SCOPE_AGENT)), 1e-30f) * (1.0f / 127.0f);
    __syncthreads();
}
__device__ __forceinline__ int zmap8(int pn8) { return pn8 < 12 ? pn8 + 6 : pn8 + 18; }
template <bool Q8, bool BF = true> __device__ __forceinline__ void rms_row_bf16(const float* xrow, const float* g, bf16* orow, int lane, unsigned* qrow = nullptr, float* qinv = nullptr) {
    const f32x4* xr = (const f32x4*)xrow + lane; f32x4 v[16]; float s = 0.f;
#pragma unroll
    for (int j = 0; j < 16; ++j) { v[j] = xr[64 * j]; s += (v[j].x * v[j].x + v[j].y * v[j].y) + (v[j].z * v[j].z + v[j].w * v[j].w); }
    const float rstd = 1.0f / sqrtf(wave_sum(s) * (1.0f / DM) + EPS);
    const f32x4* gr = (const f32x4*)g + lane; u32x2* o8 = (u32x2*)orow + lane; float mx = 0.f;
#pragma unroll
    for (int j = 0; j < 16; ++j) { const f32x4 gg = gr[64 * j]; v[j].x = v[j].x * rstd * gg.x; v[j].y = v[j].y * rstd * gg.y; v[j].z = v[j].z * rstd * gg.z; v[j].w = v[j].w * rstd * gg.w;
        if (BF) { u32x2 w; w.x = cvt_pk_bf16(v[j].x, v[j].y); w.y = cvt_pk_bf16(v[j].z, v[j].w); o8[64 * j] = w; }
        if (Q8) mx = fmaxf(mx, fmaxf(fmaxf(fabsf(v[j].x), fabsf(v[j].y)), fmaxf(fabsf(v[j].z), fabsf(v[j].w)))); }
    if (Q8) {
        mx = fmaxf(wave_max(mx), 1e-30f); const float sc = 127.0f / mx;
        if (lane == 0) *qinv = mx * (1.0f / 127.0f);
#pragma unroll
        for (int j = 0; j < 16; ++j) { const int b0 = (int)rintf(v[j].x * sc), b1 = (int)rintf(v[j].y * sc), b2 = (int)rintf(v[j].z * sc), b3 = (int)rintf(v[j].w * sc);
            qrow[64 * j + lane] = (unsigned)(b0 & 255) | ((unsigned)(b1 & 255) << 8) | ((unsigned)(b2 & 255) << 16) | ((unsigned)(b3 & 255) << 24); }
    }
}
__device__ __forceinline__ void rms_row_q8_from_bf16(const bf16* xrow, const float* g, int lane, unsigned* qrow, float* qinv) {
    const u32x2* xr = (const u32x2*)xrow + lane; f32x4 v[16]; float s = 0.f;
#pragma unroll
    for (int j = 0; j < 16; ++j) { const u32x2 w = xr[64 * j]; v[j] = (f32x4){bflo(w.x), bfhi(w.x), bflo(w.y), bfhi(w.y)}; s += (v[j].x * v[j].x + v[j].y * v[j].y) + (v[j].z * v[j].z + v[j].w * v[j].w); }
    const float rstd = 1.0f / sqrtf(wave_sum(s) * (1.0f / DM) + EPS);
    const f32x4* gr = (const f32x4*)g + lane; float mx = 0.f;
#pragma unroll
    for (int j = 0; j < 16; ++j) { const f32x4 gg = gr[64 * j]; v[j].x = v[j].x * rstd * gg.x; v[j].y = v[j].y * rstd * gg.y; v[j].z = v[j].z * rstd * gg.z; v[j].w = v[j].w * rstd * gg.w;
        mx = fmaxf(mx, fmaxf(fmaxf(fabsf(v[j].x), fabsf(v[j].y)), fmaxf(fabsf(v[j].z), fabsf(v[j].w)))); }
    mx = fmaxf(wave_max(mx), 1e-30f); const float sc = 127.0f / mx;
    if (lane == 0) *qinv = mx * (1.0f / 127.0f);
#pragma unroll
    for (int j = 0; j < 16; ++j) { const int b0 = (int)rintf(v[j].x * sc), b1 = (int)rintf(v[j].y * sc), b2 = (int)rintf(v[j].z * sc), b3 = (int)rintf(v[j].w * sc);
        qrow[64 * j + lane] = (unsigned)(b0 & 255) | ((unsigned)(b1 & 255) << 8) | ((unsigned)(b2 & 255) << 16) | ((unsigned)(b3 & 255) << 24); }
}
__device__ __forceinline__ int t5_bucket(int dist) {
    if (dist < 16) return dist;
    const float d = (float)dist; int large = 16 + (int)(logf(d / 16.0f) / 4.852030263919617f * 16.0f);
    return large < 31 ? large : 31;
}
__device__ __forceinline__ void tables_phase(const Args& a, LAS unsigned char* L, int tid, int lane, int wave, int G) {
    unsigned char* ws = a.ws;
    const f32x4* su = (const f32x4*)a.in[I_PU]; const f32x4* sv = (const f32x4*)a.in[I_PV]; u32x4* du = (u32x4*)(ws + WS_U); u32x4* dv = (u32x4*)(ws + WS_V);
        for (int it = blockIdx.x; it < 2 * (PNE / 16); it += G) {
            const bool isv = it >= PNE / 16; const int e0 = 16 * (isv ? it - PNE / 16 : it);
            const f32x4* src = (isv ? sv : su) + (size_t)e0 * (DM / 4); u32x4* dst = isv ? dv : du;
            LAS float* red = (LAS float*)(L + 65536);
            f32x4 p[16], q[16];
#pragma unroll
            for (int i = 0; i < 16; ++i) { const int ch = i * 512 + tid; p[i] = src[2 * ch]; q[i] = src[2 * ch + 1]; }
#pragma unroll
            for (int i = 0; i < 16; ++i) { float m = fmaxf(fmaxf(fmaxf(fabsf(p[i].x), fabsf(p[i].y)), fmaxf(fabsf(p[i].z), fabsf(p[i].w))), fmaxf(fmaxf(fabsf(q[i].x), fabsf(q[i].y)), fmaxf(fabsf(q[i].z), fabsf(q[i].w))));
                m = wave_max(m); if (lane == 0) red[i * 8 + wave] = m; }
            __syncthreads();
#pragma unroll
            for (int i = 0; i < 16; ++i) {
                float m = red[i * 8];
#pragma unroll
                for (int w = 1; w < 8; ++w) m = fmaxf(m, red[i * 8 + w]);
                m = fmaxf(m, 1e-30f);
                const float sc = (isv ? 224.0f : 127.0f) / m;
                if (tid == i) ((float*)(ws + (isv ? WS_SV : WS_SU)))[e0 + i] = m * (isv ? (1.0f / 224.0f) : (1.0f / 127.0f));
                u32x2 w2;
                if (isv) { int a0 = __builtin_amdgcn_cvt_pk_fp8_f32(p[i].x * sc, p[i].y * sc, 0, false); a0 = __builtin_amdgcn_cvt_pk_fp8_f32(p[i].z * sc, p[i].w * sc, a0, true);
                           int a1 = __builtin_amdgcn_cvt_pk_fp8_f32(q[i].x * sc, q[i].y * sc, 0, false); a1 = __builtin_amdgcn_cvt_pk_fp8_f32(q[i].z * sc, q[i].w * sc, a1, true); w2.x = (unsigned)a0; w2.y = (unsigned)a1; }
                else { const int b0 = (int)rintf(p[i].x * sc), b1 = (int)rintf(p[i].y * sc), b2 = (int)rintf(p[i].z * sc), b3 = (int)rintf(p[i].w * sc), b4 = (int)rintf(q[i].x * sc), b5 = (int)rintf(q[i].y * sc), b6 = (int)rintf(q[i].z * sc), b7 = (int)rintf(q[i].w * sc);
                       w2.x = (unsigned)(b0 & 255) | ((unsigned)(b1 & 255) << 8) | ((unsigned)(b2 & 255) << 16) | ((unsigned)(b3 & 255) << 24); w2.y = (unsigned)(b4 & 255) | ((unsigned)(b5 & 255) << 8) | ((unsigned)(b6 & 255) << 16) | ((unsigned)(b7 & 255) << 24); }
                *(LAS u32x2*)(L + (size_t)i * 4096 + tid * 8) = w2;
            }
            __syncthreads();
#pragma unroll
            for (int i = 0; i < 8; ++i) { const int o = i * 512 + tid, sl = o >> 7, rem = o & 127, er = rem >> 3, cc = rem & 7;
                dst[(size_t)sl * ((size_t)PNE * 8) + (size_t)(e0 + er) * 8 + cc] = *(const LAS u32x4*)(L + (size_t)er * 4096 + sl * 128 + cc * 16); }
            __syncthreads();
        }
}
#ifndef PROBE_DOUBLE
#define PROBE_DOUBLE 0
#endif
#define REP0(k) for (int rep0_ = 0; rep0_ < 1 + (((PROBE_DOUBLE) >> (k)) & 1); ++rep0_)
__device__ __forceinline__ void q8_chunk_item(const Args& a, int c, int i, bool tr, LAS unsigned char* L, int tid) {
    unsigned char* ws = a.ws; unsigned* CM = (unsigned*)(ws + WS_CTL) + CW_CM;
    const float* W; int N, n0, k0; unsigned* cm; unsigned char* WT8; float* sw;
    if (c < 10 || i < 64) { const int nt = c < 10 ? 8 : 2; const int kb = i / nt, pn = 8 * c + i % nt; W = a.in[I_WIN]; N = INC; n0 = 256 * pn; k0 = 128 * kb; cm = CM + 256 * pn; WT8 = ws + WS_WIN8; sw = (float*)(ws + WS_SW8); }
    else { const int r = i - 64, kb = r >> 3, pq = r & 7; W = a.in[I_PWQ]; N = PQW; n0 = 256 * pq; k0 = 128 * kb; cm = CM + INC + 256 * pq; WT8 = ws + WS_WQ8; sw = (float*)(ws + WS_SWQ); }
    if (!tr) { colmax_tile(W, N, n0, k0, cm, (LAS float*)L, tid); return; }
    const int pnz = (N == INC) ? (n0 >> 8) : 99;
    if (pnz < 6 || (pnz >= 18 && pnz < 30)) { const int pb = pnz < 6 ? pnz : pnz - 12; transpose_tile_q8<true>(W, N, n0, k0, cm, WT8, n0, sw, L, tid, (bf16*)(ws + WS_WINB) + (size_t)256 * pb * DM); }
    else transpose_tile_q8<false>(W, N, n0, k0, cm, WT8, n0, sw, L, tid);
}
__device__ __forceinline__ void p0_prologue(const Args& a, LAS unsigned char* L, int tid, int lane, int wave, int G) {
    unsigned char* ws = a.ws;
    LAS float* scr = (LAS float*)(L + wave * 16384);
    const int gw = blockIdx.x * 8 + wave, NGW = G * 8;
    REP0(16) {
        unsigned* cnt0 = (unsigned*)(ws + WS_CTL) + CW_CMDONE; unsigned* tmo = (unsigned*)(ws + WS_CTL) + CW_BAR + XB_TMO;
#pragma unroll 1
        for (int c = 0; c <= 11; ++c) {
            if (c < 11) {
                const int ni = c < 10 ? 256 : 320;
                for (int i = blockIdx.x; i < ni; i += G) q8_chunk_item(a, c, i, false, L, tid);
                asm volatile("s_waitcnt vmcnt(0)" ::: "memory"); __syncthreads();
                if (tid == 0) __hip_atomic_fetch_add(cnt0 + 64 * c, 1u, __ATOMIC_RELAXED, __HIP_MEMORY_SCOPE_AGENT);
            }
            if (c >= 1) {
                const int p = c - 1;
                if (tid == 0) { unsigned sp = 0;
                    while (__hip_atomic_load(cnt0 + 64 * p, __ATOMIC_RELAXED, __HIP_MEMORY_SCOPE_AGENT) < (unsigned)G) { __builtin_amdgcn_s_sleep(2);
                        if ((++sp & 255u) == 0u) { if (__hip_atomic_load(tmo, __ATOMIC_RELAXED, __HIP_MEMORY_SCOPE_AGENT)) break; if (sp > (1u << 20)) { atomicAdd(tmo, 1u); break; } } }
                    __builtin_amdgcn_fence(__ATOMIC_ACQUIRE, "agent"); asm volatile("s_waitcnt vmcnt(0)" ::: "memory"); }
                __syncthreads();
                const int ni = p < 10 ? 256 : 320;
                for (int i = blockIdx.x; i < ni; i += G) q8_chunk_item(a, p, i, true, L, tid);
            }
        }
        constexpr int T_INB = 0, T_MKV = (DM / 128) * (2048 / 256), T_BA = (LRUW / 128) * (DM / 256), T_BB = (512 / 128) * (DM / 256), T_BM = (1024 / 128) * (DM / 256), T_OUT = (DM / 128) * (DM / 256);
        constexpr int NTT = T_INB + T_MKV + T_BA + T_BB + T_BM + T_OUT;
        for (int it = G - 1 - (int)blockIdx.x; it < NTT; it += G) {
            int r = it;
            if (r < T_MKV) { transpose_tile(a.in[I_WMKV], DM, 2048, (bf16*)(ws + WS_WMKV), DM, 0, L, r, tid); continue; } r -= T_MKV;
            if (r < T_BA) { transpose_tile(a.in[I_WBA], LRUW, DM, (bf16*)(ws + WS_WCAT), KCAT, 0, L, r, tid); continue; } r -= T_BA;
            if (r < T_BB) { transpose_tile(a.in[I_WBB], 512, DM, (bf16*)(ws + WS_WCAT), KCAT, 1536, L, r, tid); continue; } r -= T_BB;
            if (r < T_BM) { transpose_tile(a.in[I_WBM], 1024, DM, (bf16*)(ws + WS_WCAT), KCAT, 2048, L, r, tid); continue; } r -= T_BM;
            transpose_tile(a.in[I_WOUT], DM, DM, (bf16*)(ws + WS_WOUT), DM, 0, L, r, tid);
        }
        for (int it = NGW - 1 - gw; it < 24 * 8; it += NGW) { const int mj = it >> 3, sub = it & 7; const float* W = (mj < 12 ? a.in[I_LWA] + (size_t)mj * 16384 : a.in[I_LWI] + (size_t)(mj - 12) * 16384);
            transpose_item(W, 128, 128, (bf16*)(ws + WS_LRUW) + (size_t)mj * 16384, 128, 0, scr, sub, lane); }
        __syncthreads();
    }
    if (blockIdx.x == 1 % G) { float* sp = (float*)(ws + WS_SPLUS); for (int i = tid; i < LRUW; i += 512) sp[i] = log1pf(expf(-a.in[I_LAM][i])); }
    REP0(17) for (int m = (gw + NGW - NGW / 4) % NGW; m < MALL + 1024; m += NGW) {
        if (m < MP) rms_row_bf16<true>(a.in[I_XP] + (size_t)m * DM, a.in[I_N1G], (bf16*)(ws + WS_XN) + (size_t)m * DM, lane, (unsigned*)(ws + WS_XN8) + (size_t)m * (DM / 4), (float*)(ws + WS_SA) + m);
        else if (m < MREAL) rms_row_bf16<true>(a.in[I_XS] + (size_t)(m - MP) * DM, a.in[I_N1G], (bf16*)(ws + WS_XN) + (size_t)m * DM, lane, (unsigned*)(ws + WS_XN8) + (size_t)m * (DM / 4), (float*)(ws + WS_SA) + m);
        else if (m < MALL) { u32x4* o = (u32x4*)((bf16*)(ws + WS_XN) + (size_t)m * DM) + lane;
#pragma unroll
            for (int j = 0; j < 8; ++j) o[64 * j] = (u32x4){0u, 0u, 0u, 0u}; }
        else rms_row_bf16<false>(a.in[I_MEMP] + (size_t)(m - MALL) * DM, a.in[I_MNG], (bf16*)(ws + WS_MEMN) + (size_t)(m - MALL) * DM, lane);
    }
}
__device__ __forceinline__ void p0b_prologue(const Args& a, LAS unsigned char* L, int tid, int lane, int wave, int G) {
    unsigned char* ws = a.ws;
    const size_t gt = (size_t)blockIdx.x * 512 + tid, NTH = (size_t)G * 512;
    REP0(18) {
        __syncthreads();
        tables_phase(a, L, tid, lane, wave, G);
        const size_t k8 = (size_t)8 * 2 * 128 * 128 / 8; const f32x4* sk = (const f32x4*)a.in[I_PSUB]; u32x4* dk = (u32x4*)(ws + WS_SUBK);
        for (size_t i = gt; i < k8; i += NTH) { const f32x4 p = sk[2 * i], q = sk[2 * i + 1]; u32x4 w; w.x = cvt_pk_bf16(p.x, p.y); w.y = cvt_pk_bf16(p.z, p.w); w.z = cvt_pk_bf16(q.x, q.y); w.w = cvt_pk_bf16(q.z, q.w); dk[i] = w; }
    }
    REP0(19) {
#pragma unroll
        for (int g = 0; g < 3; ++g) {
            const int Wb = (g == 0) ? 128 : (g == 1) ? 512 : 2048; const size_t per_b = (size_t)(Wb - 1) * 256;
            const f32x4* src = (const f32x4*)a.in[I_C0 + g]; f32x4* dst = (f32x4*)(a.out + ((g == 0) ? OUT_SSWA0 : (g == 1) ? OUT_SSWA1 : OUT_SSWA2));
            const unsigned pb = (unsigned)per_b, tot = pb * MS;
            for (unsigned i0 = (unsigned)gt; i0 < tot; i0 += 8u * (unsigned)NTH) {
                f32x4 t[8]; unsigned di[8];
#pragma unroll
                for (int j = 0; j < 8; ++j) { const unsigned f = i0 + (unsigned)j * (unsigned)NTH; if (f < tot) { const unsigned b = f / pb, rem = f - b * pb; di[j] = b * (unsigned)(Wb * 256) + rem; t[j] = __builtin_nontemporal_load(src + di[j] + 256); } }
#pragma unroll
                for (int j = 0; j < 8; ++j) { const unsigned f = i0 + (unsigned)j * (unsigned)NTH; if (f < tot) __builtin_nontemporal_store(t[j], dst + di[j]); }
            }
        }
        for (size_t i = gt; i < (size_t)MS * 2 * LRUW; i += NTH) { const size_t b = i / (2 * LRUW), rem = i - b * (2 * LRUW); a.out[OUT_SCONV + b * 3 * LRUW + rem] = a.in[I_SCONV][b * 3 * LRUW + LRUW + rem]; }
    }
    if (blockIdx.x == 0) {
        float* bt = (float*)(ws + WS_BIAS);
        for (int i = tid; i < 3 * 129 * 4; i += 512) { const int g = i / (129 * 4), off = (i / 4) % 129, hh = i & 3; const int dil = 1 << (2 * g);
            bt[i] = a.in[I_RELB][t5_bucket(off * dil) * NDH + 4 * g + hh]; }
    }
}

__device__ __forceinline__ void lru_ab(float R, float I, float sp, float xc, float& a, float& b) {
    const float r = sigmoidf_(R), ig = sigmoidf_(I);
    a = fast_exp(-8.0f * r * sp); b = sqrtf(fmaxf(1.0f - a * a, 0.f)) * (ig * xc);
}
__device__ __forceinline__ void lru_local_item(const Args& a, LAS unsigned char* L, int tid, int lane, int wave, int it) {
    unsigned char* ws = a.ws; tid = launder(tid); lane = launder(lane);
    const int b = it / 192, c = (it / 12) % 16, n = it % 12;
    const bf16* Z = (const bf16*)(ws + WS_Z);
    LAS unsigned char* XC = L; LAS unsigned char* WA = L + 34816; LAS unsigned char* WI = L + 69632;
    LAS float* AF = (LAS float*)L; LAS float* BF = (LAS float*)(L + 66048);
    {
        const bf16* wa = (const bf16*)(ws + WS_LRUW) + (size_t)n * 16384; const bf16* wi = (const bf16*)(ws + WS_LRUW) + (size_t)(12 + n) * 16384;
#pragma unroll
        for (int j = 0; j < 4; ++j) { const int task = j * 512 + tid, row = task >> 4, ch = task & 15;
            *(LAS u32x4*)(WA + row * 272 + ch * 16) = *(const u32x4*)(wa + row * 128 + ch * 8);
            *(LAS u32x4*)(WI + row * 272 + ch * 16) = *(const u32x4*)(wi + row * 128 + ch * 8); }
        if (tid < 384) { const int k = tid >> 7, o = tid & 127; const float* srcp = (k == 0) ? a.in[I_LBA] : (k == 1) ? a.in[I_LBI] : (const float*)(ws + WS_SPLUS); ((LAS float*)(L + 132096))[tid] = srcp[128 * n + o]; }
    }
    {
        const int cg = tid & 15; const int chb = 128 * n + 8 * cg;
        float cw[4][8], cb[8];
#pragma unroll
        for (int k = 0; k < 4; ++k) { const f32x4 p = *(const f32x4*)(a.in[I_CONVW] + k * LRUW + chb), q = *(const f32x4*)(a.in[I_CONVW] + k * LRUW + chb + 4);
            cw[k][0] = p.x; cw[k][1] = p.y; cw[k][2] = p.z; cw[k][3] = p.w; cw[k][4] = q.x; cw[k][5] = q.y; cw[k][6] = q.z; cw[k][7] = q.w; }
        { const f32x4 p = *(const f32x4*)(a.in[I_CONVB] + chb), q = *(const f32x4*)(a.in[I_CONVB] + chb + 4); cb[0] = p.x; cb[1] = p.y; cb[2] = p.z; cb[3] = p.w; cb[4] = q.x; cb[5] = q.y; cb[6] = q.z; cb[7] = q.w; }
#pragma unroll
        for (int j = 0; j < 4; ++j) {
            const int tt = 32 * j + (tid >> 4), t = 128 * c + tt;
            float xc[8];
#pragma unroll
            for (int e = 0; e < 8; ++e) xc[e] = cb[e];
            u32x4 xl = (u32x4){0u, 0u, 0u, 0u};
#pragma unroll
            for (int k = 0; k < 4; ++k) { const int ts = t - 3 + k; u32x4 w = (u32x4){0u, 0u, 0u, 0u};
                if (ts >= 0) w = *(const u32x4*)(Z + (size_t)(b * SEQ + ts) * INC + O_LX + chb);
                xc[0] += bflo(w.x) * cw[k][0]; xc[1] += bfhi(w.x) * cw[k][1]; xc[2] += bflo(w.y) * cw[k][2]; xc[3] += bfhi(w.y) * cw[k][3];
                xc[4] += bflo(w.z) * cw[k][4]; xc[5] += bfhi(w.z) * cw[k][5]; xc[6] += bflo(w.w) * cw[k][6]; xc[7] += bfhi(w.w) * cw[k][7];
                if (k == 3) xl = w; }
            u32x4 o; o.x = cvt_pk_bf16(xc[0], xc[1]); o.y = cvt_pk_bf16(xc[2], xc[3]); o.z = cvt_pk_bf16(xc[4], xc[5]); o.w = cvt_pk_bf16(xc[6], xc[7]);
            *(LAS u32x4*)(XC + tt * 272 + cg * 16) = o;
            if (c == 15 && tt >= 125) {
                float* pc = a.out + OUT_PCONV + ((size_t)b * 3 + (tt - 125)) * LRUW + chb;
                *(f32x4*)pc = (f32x4){bflo(xl.x), bfhi(xl.x), bflo(xl.y), bfhi(xl.y)}; *(f32x4*)(pc + 4) = (f32x4){bflo(xl.z), bfhi(xl.z), bflo(xl.w), bfhi(xl.w)}; }
        }
    }
    __syncthreads();
    const int fr = lane & 15, fq = lane >> 4;
    f32x4 ar[8], ai[8];
#pragma unroll
    for (int nt = 0; nt < 8; ++nt) { ar[nt] = (f32x4){0.f, 0.f, 0.f, 0.f}; ai[nt] = (f32x4){0.f, 0.f, 0.f, 0.f}; }
    {
        bf16x8 xf[4];
#pragma unroll
        for (int ks = 0; ks < 4; ++ks) xf[ks] = *(const LAS bf16x8*)(XC + (16 * wave + fr) * 272 + ks * 64 + fq * 16);
#pragma unroll
        for (int nt = 0; nt < 8; ++nt)
#pragma unroll
            for (int ks = 0; ks < 4; ++ks) {
                const bf16x8 wa = *(const LAS bf16x8*)(WA + (16 * nt + fr) * 272 + ks * 64 + fq * 16), wi = *(const LAS bf16x8*)(WI + (16 * nt + fr) * 272 + ks * 64 + fq * 16);
                ar[nt] = __builtin_amdgcn_mfma_f32_16x16x32_bf16(wa, xf[ks], ar[nt], 0, 0, 0);
                ai[nt] = __builtin_amdgcn_mfma_f32_16x16x32_bf16(wi, xf[ks], ai[nt], 0, 0, 0); }
    }
    const int tok = 16 * wave + fr;
    float xv[8][4];
#pragma unroll
    for (int nt = 0; nt < 8; ++nt) { const u32x2 w = *(const LAS u32x2*)(XC + tok * 272 + (16 * nt + 4 * fq) * 2); xv[nt][0] = bflo(w.x); xv[nt][1] = bfhi(w.x); xv[nt][2] = bflo(w.y); xv[nt][3] = bfhi(w.y); }
    __syncthreads();
#pragma unroll
    for (int nt = 0; nt < 8; ++nt) {
        const int o = 16 * nt + 4 * fq, ch = 128 * n + o;
        const LAS float* PR = (const LAS float*)(L + 132096); (void)ch;
        const f32x4 ba = *(const LAS f32x4*)(PR + o), bi = *(const LAS f32x4*)(PR + 128 + o), lam = *(const LAS f32x4*)(PR + 256 + o);
#pragma unroll
        for (int r = 0; r < 4; ++r) { float av, bv; lru_ab(ar[nt][r] + ba[r], ai[nt][r] + bi[r], lam[r], xv[nt][r], av, bv); AF[tok * 129 + o + r] = av; BF[tok * 129 + o + r] = bv; }
    }
    __syncthreads();
    if (tid < 128) {
        float h = 0.f, P = 1.f; bf16* hl = (bf16*)(ws + WS_HLOC) + (size_t)(b * SEQ + 128 * c) * LRUW + 128 * n + tid; bf16* pc = (bf16*)(ws + WS_PCUM) + (size_t)(b * SEQ + 128 * c) * LRUW + 128 * n + tid;
#pragma unroll 4
        for (int tt = 0; tt < 128; ++tt) { const float av = AF[tt * 129 + tid], bv = BF[tt * 129 + tid]; h = av * h + bv; P *= av; const unsigned hp = cvt_pk_bf16(h, P); hl[(size_t)tt * LRUW] = (bf16)(hp & 0xffffu); pc[(size_t)tt * LRUW] = (bf16)(hp >> 16); }
        float* ag = (float*)(ws + WS_AGG) + ((size_t)(b * 16 + c) * LRUW + 128 * n + tid) * 2; ag[0] = P; ag[1] = h;
    }
    __syncthreads();
}
__device__ __forceinline__ void lru_sample_item(const Args& a, LAS unsigned char* L, int tid, int it) {
    unsigned char* ws = a.ws; tid = launder(tid); const bf16* Z = (const bf16*)(ws + WS_Z);
    const int n = it >> 3, bq = it & 7, bl = tid >> 7, o = tid & 127, b = 4 * bq + bl, ch = 128 * n + o;
    LAS float* xs = (LAS float*)L;
    const float zs = bf2f(Z[(size_t)(MP + b) * INC + O_LX + ch]);
    float xc = a.in[I_CONVB][ch];
#pragma unroll
    for (int k = 0; k < 3; ++k) xc += a.in[I_SCONV][((size_t)b * 3 + k) * LRUW + ch] * a.in[I_CONVW][k * LRUW + ch];
    xc += zs * a.in[I_CONVW][3 * LRUW + ch];
    xs[bl * 128 + o] = xc;
    __syncthreads();
    float R = a.in[I_LBA][ch], I = a.in[I_LBI][ch];
    const float* wa = a.in[I_LWA] + (size_t)n * 16384 + o; const float* wi = a.in[I_LWI] + (size_t)n * 16384 + o;
#pragma unroll 16
    for (int i = 0; i < 128; ++i) { const float x = xs[bl * 128 + i]; R += x * wa[i * 128]; I += x * wi[i * 128]; }
    float av, bv; lru_ab(R, I, ((const float*)(ws + WS_SPLUS))[ch], xc, av, bv);
    const float h = av * a.in[I_SRNN][(size_t)b * LRUW + ch] + bv;
    a.out[OUT_SRNN + (size_t)b * LRUW + ch] = h;
    a.out[OUT_SCONV + ((size_t)b * 3 + 2) * LRUW + ch] = zs;
    const float gate = bf2f(Z[(size_t)(MP + b) * INC + O_LG + ch]);
    ((bf16*)(ws + WS_YCAT))[(size_t)(MP + b) * KCAT + ch] = (bf16)(cvt_pk_bf16(h * gelu_tanh(gate), 0.f) & 0xffffu);
    __syncthreads();
}
__device__ __forceinline__ void qknorm_row(const Args& a, int row, int lane) {
    unsigned char* ws = a.ws; lane = launder(lane); const bf16* Zr = (const bf16*)(ws + WS_Z) + (size_t)row * INC;
    const int d0 = 8 * (lane & 15);
    float gq[8], gk[8];
    { const f32x4 p = *(const f32x4*)(a.in[I_QNG] + d0), q = *(const f32x4*)(a.in[I_QNG] + d0 + 4); gq[0] = p.x; gq[1] = p.y; gq[2] = p.z; gq[3] = p.w; gq[4] = q.x; gq[5] = q.y; gq[6] = q.z; gq[7] = q.w; }
    { const f32x4 p = *(const f32x4*)(a.in[I_KNG] + d0), q = *(const f32x4*)(a.in[I_KNG] + d0 + 4); gk[0] = p.x; gk[1] = p.y; gk[2] = p.z; gk[3] = p.w; gk[4] = q.x; gk[5] = q.y; gk[6] = q.z; gk[7] = q.w; }
    const bool prompt = row < MP; const int b = prompt ? row / SEQ : row - MP, t = prompt ? row % SEQ : 0;
    u32x4 wqa[3], wka[3], wva[3], wma[2];
#pragma unroll
    for (int j = 0; j < 3; ++j) { wqa[j] = *(const u32x4*)(Zr + O_Q + 512 * j + 8 * lane); wka[j] = *(const u32x4*)(Zr + O_K + 512 * j + 8 * lane); wva[j] = *(const u32x4*)(Zr + O_V + 512 * j + 8 * lane); }
#pragma unroll
    for (int j = 0; j < 2; ++j) wma[j] = *(const u32x4*)(Zr + O_MQ + 512 * j + 8 * lane);
#pragma unroll
    for (int j = 0; j < 3; ++j) {
        const u32x4 wq = wqa[j], wk = wka[j], wv = wva[j];
        float q[8] = {bflo(wq.x), bfhi(wq.x), bflo(wq.y), bfhi(wq.y), bflo(wq.z), bfhi(wq.z), bflo(wq.w), bfhi(wq.w)};
        float k[8] = {bflo(wk.x), bfhi(wk.x), bflo(wk.y), bfhi(wk.y), bflo(wk.z), bfhi(wk.z), bflo(wk.w), bfhi(wk.w)};
        float sq = 0.f, sk = 0.f;
#pragma unroll
        for (int e = 0; e < 8; ++e) { sq += q[e] * q[e]; sk += k[e] * k[e]; }
#pragma unroll
        for (int o = 1; o < 16; o <<= 1) { sq += __shfl_xor(sq, o); sk += __shfl_xor(sk, o); }
        const float rq = 1.0f / sqrtf(sq * (1.0f / HD) + EPS), rk = 1.0f / sqrtf(sk * (1.0f / HD) + EPS);
#pragma unroll
        for (int e = 0; e < 8; ++e) { q[e] = q[e] * rq * gq[e]; k[e] = k[e] * rk * gk[e]; }
        u32x4 oq, ok; oq.x = cvt_pk_bf16(q[0], q[1]); oq.y = cvt_pk_bf16(q[2], q[3]); oq.z = cvt_pk_bf16(q[4], q[5]); oq.w = cvt_pk_bf16(q[6], q[7]);
        ok.x = cvt_pk_bf16(k[0], k[1]); ok.y = cvt_pk_bf16(k[2], k[3]); ok.z = cvt_pk_bf16(k[4], k[5]); ok.w = cvt_pk_bf16(k[6], k[7]);
        *(u32x4*)((bf16*)(ws + WS_QN) + (size_t)row * DILW + 512 * j + 8 * lane) = oq;
        *(u32x4*)((bf16*)(ws + WS_KN) + (size_t)row * DILW + 512 * j + 8 * lane) = ok;
        const int Wb = (j == 0) ? 128 : (j == 1) ? 512 : 2048;
        float* dst = nullptr;
        if (prompt) { const int r = t - (SEQ - Wb); if (r >= 0) dst = a.out + ((j == 0) ? OUT_PSWA0 : (j == 1) ? OUT_PSWA1 : OUT_PSWA2) + ((size_t)b * Wb + r) * 1024; }
        else dst = a.out + ((j == 0) ? OUT_SSWA0 : (j == 1) ? OUT_SSWA1 : OUT_SSWA2) + ((size_t)b * Wb + (Wb - 1)) * 1024;
        if (dst) {
            *(f32x4*)(dst + 8 * lane) = (f32x4){k[0], k[1], k[2], k[3]}; *(f32x4*)(dst + 8 * lane + 4) = (f32x4){k[4], k[5], k[6], k[7]};
            *(f32x4*)(dst + 512 + 8 * lane) = (f32x4){bflo(wv.x), bfhi(wv.x), bflo(wv.y), bfhi(wv.y)}; *(f32x4*)(dst + 512 + 8 * lane + 4) = (f32x4){bflo(wv.z), bfhi(wv.z), bflo(wv.w), bfhi(wv.w)};
        }
    }
    const int m0 = 8 * (lane & 31);
    float gm[8];
    { const f32x4 p = *(const f32x4*)(a.in[I_MQNG] + m0), q = *(const f32x4*)(a.in[I_MQNG] + m0 + 4); gm[0] = p.x; gm[1] = p.y; gm[2] = p.z; gm[3] = p.w; gm[4] = q.x; gm[5] = q.y; gm[6] = q.z; gm[7] = q.w; }
#pragma unroll
    for (int j = 0; j < 2; ++j) {
        const u32x4 w = wma[j];
        float q[8] = {bflo(w.x), bfhi(w.x), bflo(w.y), bfhi(w.y), bflo(w.z), bfhi(w.z), bflo(w.w), bfhi(w.w)};
        float sq = 0.f;
#pragma unroll
        for (int e = 0; e < 8; ++e) sq += q[e] * q[e];
#pragma unroll
        for (int o = 1; o < 32; o <<= 1) sq += __shfl_xor(sq, o);
        const float rq = 1.0f / sqrtf(sq * (1.0f / MEMD) + EPS);
        u32x4 oq; oq.x = cvt_pk_bf16(q[0] * rq * gm[0], q[1] * rq * gm[1]); oq.y = cvt_pk_bf16(q[2] * rq * gm[2], q[3] * rq * gm[3]);
        oq.z = cvt_pk_bf16(q[4] * rq * gm[4], q[5] * rq * gm[5]); oq.w = cvt_pk_bf16(q[6] * rq * gm[6], q[7] * rq * gm[7]);
        *(u32x4*)((bf16*)(ws + WS_MQN) + (size_t)row * MEMW + 512 * j + 8 * lane) = oq;
    }
}
__device__ __forceinline__ void memkv_row(const Args& a, int row, int lane) {
    unsigned char* ws = a.ws; lane = launder(lane); float* pr = a.out + OUT_PMEM + (size_t)row * 2048; const float* rr = (const float*)(ws + WS_MKVRAW) + (size_t)row * 2048;
    const f32x4 g = *(const f32x4*)(a.in[I_MKNG] + 4 * lane);
    f32x4 ka[4], va[4];
#pragma unroll
    for (int j = 0; j < 4; ++j) { ka[j] = *(const f32x4*)(rr + 256 * j + 4 * lane); va[j] = *(const f32x4*)(rr + 1024 + 256 * j + 4 * lane); }
#pragma unroll
    for (int j = 0; j < 4; ++j) {
        f32x4 k = ka[j];
        const float ss = wave_sum((k.x * k.x + k.y * k.y) + (k.z * k.z + k.w * k.w));
        const float rs = 1.0f / sqrtf(ss * (1.0f / MEMD) + EPS);
        k = k * rs * g;
        *(f32x4*)(pr + 256 * j + 4 * lane) = k;
        u32x2 w; w.x = cvt_pk_bf16(k.x, k.y); w.y = cvt_pk_bf16(k.z, k.w);
        *(u32x2*)((bf16*)(ws + WS_MK) + (size_t)row * 1024 + 256 * j + 4 * lane) = w;
        const f32x4 v = va[j]; *(f32x4*)(pr + 1024 + 256 * j + 4 * lane) = v;
        u32x2 wv; wv.x = cvt_pk_bf16(v.x, v.y); wv.y = cvt_pk_bf16(v.z, v.w);
        *(u32x2*)((bf16*)(ws + WS_MV) + (size_t)row * 1024 + 256 * j + 4 * lane) = wv;
    }
}
__device__ __forceinline__ void p2a_phase(const Args& a, LAS unsigned char* L, int tid, int lane, int wave, int G) {
    for (int it = blockIdx.x; it < 768 + 96; it += G) { if (it < 768) lru_local_item(a, L, tid, lane, wave, it); else lru_sample_item(a, L, tid, it - 768); }
    const int NGW = G * 8, gw = NGW - 1 - ((int)blockIdx.x * 8 + wave);
    for (int m = gw; m < MREAL + 1024; m += NGW) { if (m < MREAL) qknorm_row(a, m, lane); else memkv_row(a, m - MREAL, lane); }
}

constexpr int KLD = 272;
constexpr int VLD = 520;
constexpr int ATT_K = 0, ATT_V = 69632, ATT_B = 2 * 69632;

template <class RowPtr> __device__ __forceinline__ void stage_k(LAS unsigned char* Kl, int tid, RowPtr rowptr) {
#pragma unroll
    for (int j = 0; j < 8; ++j) { const int task = j * 512 + tid, jj = task >> 4, c = task & 15; const bf16* p = rowptr(jj);
        u32x4 w = (u32x4){0u, 0u, 0u, 0u}; if (p) w = *(const u32x4*)(p + 8 * c);
        *(LAS u32x4*)(Kl + jj * KLD + c * 16) = w; }
}
template <class RowPtr> __device__ __forceinline__ void stage_k_load(u32x4 (&w)[8], int tid, RowPtr rowptr) {
#pragma unroll
    for (int j = 0; j < 8; ++j) { const int task = j * 512 + tid, jj = task >> 4, c = task & 15; w[j] = *(const u32x4*)(rowptr(jj) + 8 * c); }
}
__device__ __forceinline__ void stage_k_store(LAS unsigned char* Kl, int tid, const u32x4 (&w)[8]) {
#pragma unroll
    for (int j = 0; j < 8; ++j) { const int task = j * 512 + tid, jj = task >> 4, c = task & 15; *(LAS u32x4*)(Kl + jj * KLD + c * 16) = w[j]; }
}
template <class RowPtr> __device__ __forceinline__ void stage_vt(LAS unsigned char* Vl, int tid, RowPtr rowptr) {
#pragma unroll
    for (int j = 0; j < 4; ++j) { const int task = j * 512 + tid, c = task >> 7, p = task & 127; const bf16* p0 = rowptr(2 * p); const bf16* p1 = rowptr(2 * p + 1);
        u32x4 x = (u32x4){0u, 0u, 0u, 0u}, y = (u32x4){0u, 0u, 0u, 0u}; if (p0) x = *(const u32x4*)(p0 + 8 * c); if (p1) y = *(const u32x4*)(p1 + 8 * c);
        LAS unsigned char* d = Vl + (8 * c) * VLD + 4 * p;
        *(LAS unsigned*)(d + 0 * VLD) = (x.x & 0xffffu) | (y.x << 16); *(LAS unsigned*)(d + 1 * VLD) = (x.x >> 16) | (y.x & 0xffff0000u);
        *(LAS unsigned*)(d + 2 * VLD) = (x.y & 0xffffu) | (y.y << 16); *(LAS unsigned*)(d + 3 * VLD) = (x.y >> 16) | (y.y & 0xffff0000u);
        *(LAS unsigned*)(d + 4 * VLD) = (x.z & 0xffffu) | (y.z << 16); *(LAS unsigned*)(d + 5 * VLD) = (x.z >> 16) | (y.z & 0xffff0000u);
        *(LAS unsigned*)(d + 6 * VLD) = (x.w & 0xffffu) | (y.w << 16); *(LAS unsigned*)(d + 7 * VLD) = (x.w >> 16) | (y.w & 0xffff0000u); }
}
typedef short s16x4_t __attribute__((ext_vector_type(4)));
__device__ __forceinline__ u32x2 v_tr_read(const LAS unsigned char* Vl, int jb, int d0, int fr) {
    const LAS unsigned char* p = Vl + (jb + (fr >> 2)) * KLD + (d0 + 4 * (fr & 3)) * 2;
    return __builtin_bit_cast(u32x2, __builtin_amdgcn_ds_read_tr16_b64_v4i16((LAS s16x4_t*)p));
}
__device__ __forceinline__ void dil_item(const Args& a, LAS unsigned char* L, int tid, int lane, int wave, int it) {
    unsigned char* ws = a.ws; tid = launder(tid); lane = launder(lane);
    const int b = it / 192, hd = (it >> 4) % 12, blk = it & 15, g = hd >> 2, hh = hd & 3, dil = 1 << (2 * g), nbk = 16 >> (2 * g), r = blk / nbk, n = blk % nbk;
    const bf16* KN = (const bf16*)(ws + WS_KN); const bf16* QN = (const bf16*)(ws + WS_QN); const bf16* Z = (const bf16*)(ws + WS_Z);
    LAS unsigned char* Kl = L + ATT_K; LAS unsigned char* Vl = L + ATT_V; LAS float* Bl = (LAS float*)(L + ATT_B);
    const int kbase = (n - 1) * 128;
    const int fr = lane & 15, fq = lane >> 4, qi = 16 * wave + fr, w0 = wave & ~1;
    const int qrow = b * SEQ + (n * 128 + qi) * dil + r;
    bf16x8 qf[4];
#pragma unroll
    for (int ks = 0; ks < 4; ++ks) qf[ks] = *(const bf16x8*)(QN + (size_t)qrow * DILW + HD * hd + 32 * ks + 8 * fq);
    stage_k(Kl, tid, [&](int jj) -> const bf16* { const int ki = kbase + jj; return ki >= 0 ? KN + (size_t)(b * SEQ + ki * dil + r) * DILW + HD * hd : nullptr; });
    stage_k(Vl, tid, [&](int jj) -> const bf16* { const int ki = kbase + jj; return ki >= 0 ? Z + (size_t)(b * SEQ + ki * dil + r) * INC + O_V + HD * hd : nullptr; });
    if (tid < 129) Bl[tid] = ((const float*)(ws + WS_BIAS))[(g * 129 + tid) * 4 + hh];
    __syncthreads();
    f32x4 s[10];
#pragma unroll
    for (int c = 0; c < 10; ++c) { s[c] = (f32x4){0.f, 0.f, 0.f, 0.f};
#pragma unroll
        for (int ks = 0; ks < 4; ++ks) { const bf16x8 kf = *(const LAS bf16x8*)(Kl + (16 * (w0 + c) + fr) * KLD + ks * 64 + fq * 16); s[c] = __builtin_amdgcn_mfma_f32_16x16x32_bf16(kf, qf[ks], s[c], 0, 0, 0); } }
    const float scale = 0.08838834764831845f;
    float mx = -3.0e38f;
#pragma unroll
    for (int c = 0; c < 10; ++c)
#pragma unroll
        for (int e = 0; e < 4; ++e) { const int jj = 16 * (w0 + c) + 4 * fq + e, off = qi + 128 - jj; const bool valid = (off >= 0) && (off <= 128) && (kbase + jj >= 0);
            const int oc = off < 0 ? 0 : (off > 128 ? 128 : off);
            const float v = valid ? s[c][e] * scale + Bl[oc] : -3.0e38f; s[c][e] = v; mx = fmaxf(mx, v); }
    mx = fmaxf(mx, __shfl_xor(mx, 16)); mx = fmaxf(mx, __shfl_xor(mx, 32));
    float den = 0.f;
#pragma unroll
    for (int c = 0; c < 10; ++c)
#pragma unroll
        for (int e = 0; e < 4; ++e) { const float p = (s[c][e] > -1.0e38f) ? fast_exp(s[c][e] - mx) : 0.f; s[c][e] = p; den += p; }
    den += __shfl_xor(den, 16); den += __shfl_xor(den, 32);
    f32x4 o[8];
#pragma unroll
    for (int dt = 0; dt < 8; ++dt) o[dt] = (f32x4){0.f, 0.f, 0.f, 0.f};
#pragma unroll
    for (int T = 0; T < 5; ++T) {
        u32x4 pw; pw.x = cvt_pk_bf16(s[2 * T][0], s[2 * T][1]); pw.y = cvt_pk_bf16(s[2 * T][2], s[2 * T][3]); pw.z = cvt_pk_bf16(s[2 * T + 1][0], s[2 * T + 1][1]); pw.w = cvt_pk_bf16(s[2 * T + 1][2], s[2 * T + 1][3]);
        const bf16x8 pf = __builtin_bit_cast(bf16x8, pw);
        const int jb = 16 * (w0 + 2 * T) + 4 * fq;
#pragma unroll
        for (int dt = 0; dt < 8; ++dt) { const u32x2 v0 = v_tr_read(Vl, jb, 16 * dt, fr), v1 = v_tr_read(Vl, jb + 16, 16 * dt, fr); u32x4 vw; vw.x = v0.x; vw.y = v0.y; vw.z = v1.x; vw.w = v1.y;
            o[dt] = __builtin_amdgcn_mfma_f32_16x16x32_bf16(__builtin_bit_cast(bf16x8, vw), pf, o[dt], 0, 0, 0); }
    }
    const float inv = 1.0f / den;
    bf16* og = (bf16*)(ws + WS_OG) + (((size_t)g * MALL + qrow) * 4 + hh) * 128 + 4 * fq;
#pragma unroll
    for (int dt = 0; dt < 8; ++dt) { u32x2 w; w.x = cvt_pk_bf16(o[dt][0] * inv, o[dt][1] * inv); w.y = cvt_pk_bf16(o[dt][2] * inv, o[dt][3] * inv); *(u32x2*)(og + 16 * dt) = w; }
    if (fq == 0) ((float*)(ws + WS_LSE))[((size_t)g * MALL + qrow) * 4 + hh] = mx + logf(den);
    __syncthreads();
}
__device__ __forceinline__ void mem_item(const Args& a, LAS unsigned char* L, int tid, int lane, int wave, int it) {
    unsigned char* ws = a.ws; tid = launder(tid); lane = launder(lane);
    const int b = it >> 6, hm = (it >> 4) & 3, qb = it & 15;
    const bf16* MK = (const bf16*)(ws + WS_MK); const bf16* MV = (const bf16*)(ws + WS_MV); const bf16* MQN = (const bf16*)(ws + WS_MQN);
    LAS unsigned char* Kl = L + ATT_K; LAS unsigned char* Vl = L + ATT_V;
    const int fr = lane & 15, fq = lane >> 4, qrow = b * SEQ + qb * 128 + 16 * wave + fr;
    f32x4 s[16];
#pragma unroll
    for (int c = 0; c < 16; ++c) s[c] = (f32x4){0.f, 0.f, 0.f, 0.f};
    bf16x8 qf[2][4];
#pragma unroll
    for (int half = 0; half < 2; ++half)
#pragma unroll
        for (int ks = 0; ks < 4; ++ks) qf[half][ks] = *(const bf16x8*)(MQN + (size_t)qrow * MEMW + MEMD * hm + 128 * half + 32 * ks + 8 * fq);
    u32x4 pre[8];
    stage_k(Kl, tid, [&](int jj) -> const bf16* { return MK + (size_t)(b * MEMT + jj) * MEMW + MEMD * hm; });
    stage_k(Vl, tid, [&](int jj) -> const bf16* { return MV + (size_t)(b * MEMT + jj) * MEMW + MEMD * hm; });
    stage_k_load(pre, tid, [&](int jj) -> const bf16* { return MK + (size_t)(b * MEMT + jj) * MEMW + MEMD * hm + 128; });
#pragma unroll
    for (int half = 0; half < 2; ++half) {
        __syncthreads();
#pragma unroll
        for (int c = 0; c < 16; ++c) {
#pragma unroll
            for (int ks = 0; ks < 4; ++ks) { const bf16x8 kf = *(const LAS bf16x8*)(Kl + (16 * c + fr) * KLD + ks * 64 + fq * 16); s[c] = __builtin_amdgcn_mfma_f32_16x16x32_bf16(kf, qf[half][ks], s[c], 0, 0, 0); }
            asm volatile("" ::: "memory"); }
        __syncthreads();
        if (half == 0) { stage_k_store(Kl, tid, pre); asm volatile("" ::: "memory");
            stage_k_load(pre, tid, [&](int jj) -> const bf16* { return MV + (size_t)(b * MEMT + jj) * MEMW + MEMD * hm + 128; }); }
    }
    const float scale = 0.0625f;
    float mx = -3.0e38f;
#pragma unroll
    for (int c = 0; c < 16; ++c)
#pragma unroll
        for (int e = 0; e < 4; ++e) { s[c][e] *= scale; mx = fmaxf(mx, s[c][e]); }
    mx = fmaxf(mx, __shfl_xor(mx, 16)); mx = fmaxf(mx, __shfl_xor(mx, 32));
    float den = 0.f;
#pragma unroll
    for (int c = 0; c < 16; ++c)
#pragma unroll
        for (int e = 0; e < 4; ++e) { const float p = fast_exp(s[c][e] - mx); s[c][e] = p; den += p; }
    den += __shfl_xor(den, 16); den += __shfl_xor(den, 32);
    const float inv = 1.0f / den;
    u32x4 pw[8];
#pragma unroll
    for (int T = 0; T < 8; ++T) { pw[T].x = cvt_pk_bf16(s[2 * T][0], s[2 * T][1]); pw[T].y = cvt_pk_bf16(s[2 * T][2], s[2 * T][3]); pw[T].z = cvt_pk_bf16(s[2 * T + 1][0], s[2 * T + 1][1]); pw[T].w = cvt_pk_bf16(s[2 * T + 1][2], s[2 * T + 1][3]); }
#pragma unroll
    for (int half = 0; half < 2; ++half) {
        if (half == 1) { stage_k_store(Vl, tid, pre); __syncthreads(); }
        f32x4 o[8];
#pragma unroll
        for (int dt = 0; dt < 8; ++dt) o[dt] = (f32x4){0.f, 0.f, 0.f, 0.f};
#pragma unroll
        for (int T = 0; T < 8; ++T) { const bf16x8 pf = __builtin_bit_cast(bf16x8, pw[T]); const int jb = 32 * T + 4 * fq;
#pragma unroll
            for (int dt = 0; dt < 8; ++dt) { const u32x2 v0 = v_tr_read(Vl, jb, 16 * dt, fr), v1 = v_tr_read(Vl, jb + 16, 16 * dt, fr); u32x4 vw; vw.x = v0.x; vw.y = v0.y; vw.z = v1.x; vw.w = v1.y;
                o[dt] = __builtin_amdgcn_mfma_f32_16x16x32_bf16(__builtin_bit_cast(bf16x8, vw), pf, o[dt], 0, 0, 0); } }
        bf16* yo = (bf16*)(ws + WS_YCAT) + (size_t)qrow * KCAT + 2048 + MEMD * hm + 128 * half + 4 * fq;
#pragma unroll
        for (int dt = 0; dt < 8; ++dt) { u32x2 w; w.x = cvt_pk_bf16(o[dt][0] * inv, o[dt][1] * inv); w.y = cvt_pk_bf16(o[dt][2] * inv, o[dt][3] * inv); *(u32x2*)(yo + 16 * dt) = w; }
        __syncthreads();
    }
}
__device__ __forceinline__ void lru_fix_item(const Args& a, int it, int lane) {
    unsigned char* ws = a.ws; lane = launder(lane);
    const int b = it / 384, c = (it / 24) % 16, ch = 64 * (it % 24) + lane;
    const float* ag = (const float*)(ws + WS_AGG) + ((size_t)b * 16 * LRUW + ch) * 2;
    float carry = 0.f;
    for (int cc = 0; cc < c; ++cc) { const f32x2 pe = *(const f32x2*)(ag + (size_t)cc * LRUW * 2); carry = pe.x * carry + pe.y; }
    const size_t row0 = (size_t)b * SEQ + 128 * c;
    const bf16* hl = (const bf16*)(ws + WS_HLOC) + row0 * LRUW + ch; const bf16* pc = (const bf16*)(ws + WS_PCUM) + row0 * LRUW + ch;
    const bf16* zg = (const bf16*)(ws + WS_Z) + row0 * INC + O_LG + ch; bf16* yo = (bf16*)(ws + WS_YCAT) + row0 * KCAT + ch;
    float h = 0.f;
    for (int t0 = 0; t0 < 128; t0 += 16) {
        bf16 hv[16], pv[16]; bf16 gv[16];
#pragma unroll
        for (int j = 0; j < 16; ++j) { hv[j] = hl[(size_t)(t0 + j) * LRUW]; pv[j] = pc[(size_t)(t0 + j) * LRUW]; gv[j] = zg[(size_t)(t0 + j) * INC]; }
#pragma unroll
        for (int j = 0; j < 16; ++j) { h = bf2f(hv[j]) + bf2f(pv[j]) * carry; yo[(size_t)(t0 + j) * KCAT] = (bf16)(cvt_pk_bf16(h * gelu_tanh(bf2f(gv[j])), 0.f) & 0xffffu); }
    }
    if (c == 15) a.out[OUT_PRNN + (size_t)b * LRUW + ch] = h;
}
__device__ __forceinline__ void dil_sample_item(const Args& a, int it, int lane) {
    unsigned char* ws = a.ws; lane = launder(lane);
    const int b = it / 12, hd = it % 12, g = hd >> 2, hh = hd & 3, dil = 1 << (2 * g), Wb = (g == 0) ? 128 : (g == 1) ? 512 : 2048, row = MP + b;
    const float* cache = a.in[I_C0 + g] + (size_t)b * Wb * 1024 + hh * 128 + 2 * lane;
    const bf16* Z = (const bf16*)(ws + WS_Z);
    const unsigned qw = *(const unsigned*)((const bf16*)(ws + WS_QN) + (size_t)row * DILW + HD * hd + 2 * lane);
    const float q0 = bflo(qw), q1 = bfhi(qw);
    const float* bias = (const float*)(ws + WS_BIAS) + (size_t)g * 129 * 4 + hh;
    const float scale = 0.08838834764831845f;
    float sc[3] = {-3.0e38f, -3.0e38f, -3.0e38f};
    {
        const unsigned kw = *(const unsigned*)((const bf16*)(ws + WS_KN) + (size_t)row * DILW + HD * hd + 2 * lane);
        const float d = wave_sum(q0 * bflo(kw) + q1 * bfhi(kw)) * scale + bias[0];
        if (lane == 0) sc[0] = d;
    }
#pragma unroll 4
    for (int j = 1; j <= 128; ++j) { const f32x2 kv = *(const f32x2*)(cache + (size_t)(Wb - j * dil) * 1024);
        const float d = wave_sum(q0 * kv.x + q1 * kv.y) * scale + bias[j * 4];
        if (lane == (j & 63)) { if (j < 64) sc[0] = d; else if (j < 128) sc[1] = d; else sc[2] = d; } }
    float mx = wave_max(fmaxf(fmaxf(sc[0], sc[1]), sc[2]));
    float p[3];
#pragma unroll
    for (int k = 0; k < 3; ++k) p[k] = (sc[k] > -1.0e38f) ? fast_exp(sc[k] - mx) : 0.f;
    const float den = wave_sum(p[0] + p[1] + p[2]);
    float o0, o1;
    {   const unsigned vw = *(const unsigned*)(Z + (size_t)row * INC + O_V + HD * hd + 2 * lane); const float pj = __shfl(p[0], 0); o0 = pj * bflo(vw); o1 = pj * bfhi(vw); }
#pragma unroll 4
    for (int j = 1; j <= 128; ++j) { const f32x2 vv = *(const f32x2*)(cache + (size_t)(Wb - j * dil) * 1024 + 512);
        const float pj = __shfl((j < 64) ? p[0] : (j < 128) ? p[1] : p[2], j & 63); o0 += pj * vv.x; o1 += pj * vv.y; }
    const float inv = 1.0f / den;
    *(unsigned*)((bf16*)(ws + WS_OG) + (((size_t)g * MALL + row) * 4 + hh) * 128 + 2 * lane) = cvt_pk_bf16(o0 * inv, o1 * inv);
    if (lane == 0) ((float*)(ws + WS_LSE))[((size_t)g * MALL + row) * 4 + hh] = mx + logf(den);
}
__device__ __forceinline__ void mem_sample_item(const Args& a, int it, int lane) {
    unsigned char* ws = a.ws; lane = launder(lane);
    const int b = it >> 2, hm = it & 3, row = MP + b;
    const float* cache = a.in[I_CMEM] + (size_t)b * MEMT * 2048 + hm * 256 + 4 * lane;
    const u32x2 qw = *(const u32x2*)((const bf16*)(ws + WS_MQN) + (size_t)row * MEMW + MEMD * hm + 4 * lane);
    const float q0 = bflo(qw.x), q1 = bfhi(qw.x), q2 = bflo(qw.y), q3 = bfhi(qw.y);
    float sc[4] = {0.f, 0.f, 0.f, 0.f};
#pragma unroll 4
    for (int m = 0; m < 256; ++m) { const f32x4 kv = *(const f32x4*)(cache + (size_t)m * 2048);
        const float d = wave_sum((q0 * kv.x + q1 * kv.y) + (q2 * kv.z + q3 * kv.w)) * 0.0625f;
        if (lane == (m & 63)) { if (m < 64) sc[0] = d; else if (m < 128) sc[1] = d; else if (m < 192) sc[2] = d; else sc[3] = d; } }
    const float mx = wave_max(fmaxf(fmaxf(sc[0], sc[1]), fmaxf(sc[2], sc[3])));
    float p[4];
#pragma unroll
    for (int k = 0; k < 4; ++k) p[k] = fast_exp(sc[k] - mx);
    const float den = wave_sum((p[0] + p[1]) + (p[2] + p[3]));
    f32x4 o = (f32x4){0.f, 0.f, 0.f, 0.f};
#pragma unroll 4
    for (int m = 0; m < 256; ++m) { const f32x4 vv = *(const f32x4*)(cache + (size_t)m * 2048 + 1024);
        const float pj = __shfl((m < 64) ? p[0] : (m < 128) ? p[1] : (m < 192) ? p[2] : p[3], m & 63); o += vv * pj; }
    const float inv = 1.0f / den;
    u32x2 w; w.x = cvt_pk_bf16(o.x * inv, o.y * inv); w.y = cvt_pk_bf16(o.z * inv, o.w * inv);
    *(u32x2*)((bf16*)(ws + WS_YCAT) + (size_t)row * KCAT + 2048 + MEMD * hm + 4 * lane) = w;
}

template <int D, bool DIL> __device__ __forceinline__ void sample_attn_item(const Args& a, LAS unsigned char* L, int wave, int it) {
    unsigned char* ws = a.ws; const int lane = launder(lane_id()), tid = wave * 64 + lane, gq = lane >> 4, li = lane & 15;
    constexpr int DL = D / 16, NV = DL / 4, KPW = DIL ? 16 : 32;
    LAS float* OL = (LAS float*)L;
    LAS float* ML = (LAS float*)(L + 8 * D * 4);
    int b, hd, g = 0, hh = 0, dil = 1, Wb = 0, row; const float* kbase; float scale; const float* bias = nullptr;
    if (DIL) { b = it / 12; hd = it % 12; g = hd >> 2; hh = hd & 3; dil = 1 << (2 * g); Wb = (g == 0) ? 128 : (g == 1) ? 512 : 2048; row = MP + b;
        kbase = a.in[I_C0 + g] + (size_t)b * Wb * 1024 + hh * 128 + DL * li; scale = 0.08838834764831845f; bias = (const float*)(ws + WS_BIAS) + (size_t)g * 129 * 4 + hh; }
    else { b = it >> 2; hd = it & 3; row = MP + b; kbase = a.in[I_CMEM] + (size_t)b * MEMT * 2048 + hd * 256 + DL * li; scale = 0.0625f; }
    constexpr int KSTR = DIL ? 1024 : 2048, VOFF = DIL ? 512 : 1024;
    float q[DL];
    {   const bf16* qp = DIL ? (const bf16*)(ws + WS_QN) + (size_t)row * DILW + HD * hd + DL * li : (const bf16*)(ws + WS_MQN) + (size_t)row * MEMW + MEMD * hd + DL * li;
#pragma unroll
        for (int e = 0; e < DL; e += 2) { const unsigned w = *(const unsigned*)(qp + e); q[e] = bflo(w); q[e + 1] = bfhi(w); } }
    float mloc = -3.0e38f, lloc = 0.f; float o[DL];
#pragma unroll
    for (int e = 0; e < DL; ++e) o[e] = 0.f;
#pragma unroll
    for (int rd = 0; rd < KPW / 16; ++rd) {
        f32x4 kv[4][NV]; float sc[4];
#pragma unroll
        for (int kk = 0; kk < 4; ++kk) { const int j = KPW * wave + 16 * rd + 4 * gq + kk;
            const float* kp = kbase + (size_t)(DIL ? (Wb - (j + 1) * dil) : j) * KSTR;
#pragma unroll
            for (int v = 0; v < NV; ++v) kv[kk][v] = *(const f32x4*)(kp + 4 * v); }
#pragma unroll
        for (int kk = 0; kk < 4; ++kk) { float d = 0.f;
#pragma unroll
            for (int v = 0; v < NV; ++v) d += (q[4 * v] * kv[kk][v].x + q[4 * v + 1] * kv[kk][v].y) + (q[4 * v + 2] * kv[kk][v].z + q[4 * v + 3] * kv[kk][v].w);
            d += __shfl_xor(d, 1); d += __shfl_xor(d, 2); d += __shfl_xor(d, 4); d += __shfl_xor(d, 8);
            const int j = KPW * wave + 16 * rd + 4 * gq + kk;
            sc[kk] = d * scale + (DIL ? bias[(j + 1) * 4] : 0.f); }
        float mr = fmaxf(fmaxf(sc[0], sc[1]), fmaxf(sc[2], sc[3])); mr = fmaxf(mr, __shfl_xor(mr, 16)); mr = fmaxf(mr, __shfl_xor(mr, 32));
        const float mn = fmaxf(mloc, mr), f = fast_exp(mloc - mn);
        float pr[4], ps = 0.f;
#pragma unroll
        for (int kk = 0; kk < 4; ++kk) { pr[kk] = fast_exp(sc[kk] - mn); ps += pr[kk]; }
        ps += __shfl_xor(ps, 16); ps += __shfl_xor(ps, 32);
        lloc = lloc * f + ps; mloc = mn;
#pragma unroll
        for (int kk = 0; kk < 4; ++kk) { const int j = KPW * wave + 16 * rd + 4 * gq + kk; const float* vp = kbase + (size_t)(DIL ? (Wb - (j + 1) * dil) : j) * KSTR + VOFF;
#pragma unroll
            for (int v = 0; v < NV; ++v) kv[kk][v] = *(const f32x4*)(vp + 4 * v); }
#pragma unroll
        for (int e = 0; e < DL; ++e) o[e] *= f;
#pragma unroll
        for (int kk = 0; kk < 4; ++kk)
#pragma unroll
            for (int v = 0; v < NV; ++v) { o[4 * v] += pr[kk] * kv[kk][v].x; o[4 * v + 1] += pr[kk] * kv[kk][v].y; o[4 * v + 2] += pr[kk] * kv[kk][v].z; o[4 * v + 3] += pr[kk] * kv[kk][v].w; }
    }
#pragma unroll
    for (int e = 0; e < DL; ++e) { o[e] += __shfl_xor(o[e], 16); o[e] += __shfl_xor(o[e], 32); }
    if (DIL && wave == 0) {
        const bf16* kp = (const bf16*)(ws + WS_KN) + (size_t)row * DILW + HD * hd + DL * li; const bf16* vp = (const bf16*)(ws + WS_Z) + (size_t)row * INC + O_V + HD * hd + DL * li;
        float d = 0.f; float vv[DL];
#pragma unroll
        for (int e = 0; e < DL; e += 2) { const unsigned w = *(const unsigned*)(kp + e), x = *(const unsigned*)(vp + e); d += q[e] * bflo(w) + q[e + 1] * bfhi(w); vv[e] = bflo(x); vv[e + 1] = bfhi(x); }
        d += __shfl_xor(d, 1); d += __shfl_xor(d, 2); d += __shfl_xor(d, 4); d += __shfl_xor(d, 8);
        const float s0 = d * scale + bias[0]; const float mn = fmaxf(mloc, s0), f = fast_exp(mloc - mn), p0 = fast_exp(s0 - mn);
        lloc = lloc * f + p0; mloc = mn;
#pragma unroll
        for (int e = 0; e < DL; ++e) o[e] = o[e] * f + p0 * vv[e];
    }
    if (gq == 0) {
#pragma unroll
        for (int e = 0; e < DL; ++e) OL[wave * D + DL * li + e] = o[e];
        if (li == 0) { ML[wave * 2] = mloc; ML[wave * 2 + 1] = lloc; }
    }
    __syncthreads();
    if (tid < D) {
        float M = -3.0e38f;
#pragma unroll
        for (int w = 0; w < 8; ++w) M = fmaxf(M, ML[w * 2]);
        float Ls = 0.f, ov = 0.f;
#pragma unroll
        for (int w = 0; w < 8; ++w) { const float f = fast_exp(ML[w * 2] - M); Ls += ML[w * 2 + 1] * f; ov += OL[w * D + tid] * f; }
        ov /= Ls;
        if (DIL) { ((bf16*)(ws + WS_OG))[(((size_t)g * MALL + row) * 4 + hh) * 128 + tid] = (bf16)(cvt_pk_bf16(ov, 0.f) & 0xffffu); if (tid == 0) ((float*)(ws + WS_LSE))[((size_t)g * MALL + row) * 4 + hh] = M + logf(Ls); }
        else ((bf16*)(ws + WS_YCAT))[(size_t)row * KCAT + 2048 + MEMD * hd + tid] = (bf16)(cvt_pk_bf16(ov, 0.f) & 0xffffu);
    }
    __syncthreads();
}

__device__ __forceinline__ void dil_sample_wave(const Args& a, int it, int lane) {
    unsigned char* ws = a.ws; lane = launder(lane); const int gq = lane >> 4, li = lane & 15;
    const int b = it / 12, hd = it % 12, g = hd >> 2, hh = hd & 3, dil = 1 << (2 * g), Wb = (g == 0) ? 128 : (g == 1) ? 512 : 2048, row = MP + b;
    const float* kbase = a.in[I_C0 + g] + (size_t)b * Wb * 1024 + hh * 128 + 8 * li; const float scale = 0.08838834764831845f; const float* bias = (const float*)(ws + WS_BIAS) + (size_t)g * 129 * 4 + hh;
    float q[8];
    {   const u32x4 w = *(const u32x4*)((const bf16*)(ws + WS_QN) + (size_t)row * DILW + HD * hd + 8 * li);
        q[0] = bflo(w.x); q[1] = bfhi(w.x); q[2] = bflo(w.y); q[3] = bfhi(w.y); q[4] = bflo(w.z); q[5] = bfhi(w.z); q[6] = bflo(w.w); q[7] = bfhi(w.w); }
    float mloc = -3.0e38f, lloc = 0.f, o[8];
#pragma unroll
    for (int e = 0; e < 8; ++e) o[e] = 0.f;
    for (int rd = 0; rd < 8; ++rd) {
        f32x4 kk[4][2], vv[4][2];
#pragma unroll
        for (int c = 0; c < 4; ++c) { const int j = 16 * rd + 4 * gq + c; const float* kp = kbase + (size_t)(Wb - (j + 1) * dil) * 1024;
            kk[c][0] = *(const f32x4*)kp; kk[c][1] = *(const f32x4*)(kp + 4); vv[c][0] = *(const f32x4*)(kp + 512); vv[c][1] = *(const f32x4*)(kp + 516); }
        float sc[4];
#pragma unroll
        for (int c = 0; c < 4; ++c) { float d = (q[0] * kk[c][0].x + q[1] * kk[c][0].y) + (q[2] * kk[c][0].z + q[3] * kk[c][0].w) + (q[4] * kk[c][1].x + q[5] * kk[c][1].y) + (q[6] * kk[c][1].z + q[7] * kk[c][1].w);
            d += __shfl_xor(d, 1); d += __shfl_xor(d, 2); d += __shfl_xor(d, 4); d += __shfl_xor(d, 8);
            sc[c] = d * scale + bias[(16 * rd + 4 * gq + c + 1) * 4]; }
        float mr = fmaxf(fmaxf(sc[0], sc[1]), fmaxf(sc[2], sc[3])); mr = fmaxf(mr, __shfl_xor(mr, 16)); mr = fmaxf(mr, __shfl_xor(mr, 32));
        const float mn = fmaxf(mloc, mr), f = fast_exp(mloc - mn);
        float pr[4], ps = 0.f;
#pragma unroll
        for (int c = 0; c < 4; ++c) { pr[c] = fast_exp(sc[c] - mn); ps += pr[c]; }
        ps += __shfl_xor(ps, 16); ps += __shfl_xor(ps, 32);
        lloc = lloc * f + ps; mloc = mn;
#pragma unroll
        for (int e = 0; e < 8; ++e) o[e] *= f;
#pragma unroll
        for (int c = 0; c < 4; ++c) { o[0] += pr[c] * vv[c][0].x; o[1] += pr[c] * vv[c][0].y; o[2] += pr[c] * vv[c][0].z; o[3] += pr[c] * vv[c][0].w; o[4] += pr[c] * vv[c][1].x; o[5] += pr[c] * vv[c][1].y; o[6] += pr[c] * vv[c][1].z; o[7] += pr[c] * vv[c][1].w; }
    }
#pragma unroll
    for (int e = 0; e < 8; ++e) { o[e] += __shfl_xor(o[e], 16); o[e] += __shfl_xor(o[e], 32); }
    {
        const u32x4 kw = *(const u32x4*)((const bf16*)(ws + WS_KN) + (size_t)row * DILW + HD * hd + 8 * li), vw = *(const u32x4*)((const bf16*)(ws + WS_Z) + (size_t)row * INC + O_V + HD * hd + 8 * li);
        float d = (q[0] * bflo(kw.x) + q[1] * bfhi(kw.x)) + (q[2] * bflo(kw.y) + q[3] * bfhi(kw.y)) + (q[4] * bflo(kw.z) + q[5] * bfhi(kw.z)) + (q[6] * bflo(kw.w) + q[7] * bfhi(kw.w));
        d += __shfl_xor(d, 1); d += __shfl_xor(d, 2); d += __shfl_xor(d, 4); d += __shfl_xor(d, 8);
        const float s0 = d * scale + bias[0], mn = fmaxf(mloc, s0), f = fast_exp(mloc - mn), p0 = fast_exp(s0 - mn);
        lloc = lloc * f + p0; mloc = mn;
        const float v8[8] = {bflo(vw.x), bfhi(vw.x), bflo(vw.y), bfhi(vw.y), bflo(vw.z), bfhi(vw.z), bflo(vw.w), bfhi(vw.w)};
#pragma unroll
        for (int e = 0; e < 8; ++e) o[e] = o[e] * f + p0 * v8[e];
    }
    if (gq == 0) { const float inv = 1.0f / lloc; u32x4 w; w.x = cvt_pk_bf16(o[0] * inv, o[1] * inv); w.y = cvt_pk_bf16(o[2] * inv, o[3] * inv); w.z = cvt_pk_bf16(o[4] * inv, o[5] * inv); w.w = cvt_pk_bf16(o[6] * inv, o[7] * inv);
        *(u32x4*)((bf16*)(ws + WS_OG) + (((size_t)g * MALL + row) * 4 + hh) * 128 + 8 * li) = w;
        if (li == 0) ((float*)(ws + WS_LSE))[((size_t)g * MALL + row) * 4 + hh] = mloc + logf(lloc); }
}
__device__ __forceinline__ void p2b_phase(const Args& a, LAS unsigned char* L, int tid, int lane, int wave, int G) {
    for (int it = blockIdx.x; it < 768 + 256 + 128; it += G) {
        if (it < 768) dil_item(a, L, tid, lane, wave, it); else if (it < 1024) mem_item(a, L, tid, lane, wave, it - 768); else sample_attn_item<256, false>(a, L, wave, it - 1024);
    }
    const int gw = blockIdx.x * 8 + wave, NGW = G * 8;
    for (int it = gw; it < 1536 + 384; it += NGW) { if (it < 1536) lru_fix_item(a, it, lane); else dil_sample_wave(a, it - 1536, lane); }
}
__device__ __forceinline__ void combine_row(const Args& a, int row, int lane) {
    unsigned char* ws = a.ws; lane = launder(lane); const int hh = lane >> 4;
    const float* ls = (const float*)(ws + WS_LSE);
    const float l0 = ls[((size_t)0 * MALL + row) * 4 + hh], l1 = ls[((size_t)1 * MALL + row) * 4 + hh], l2 = ls[((size_t)2 * MALL + row) * 4 + hh];
    const float m = fmaxf(l0, fmaxf(l1, l2)); float w0 = fast_exp(l0 - m), w1 = fast_exp(l1 - m), w2 = fast_exp(l2 - m); const float inv = 1.0f / (w0 + w1 + w2); w0 *= inv; w1 *= inv; w2 *= inv;
    const bf16* og = (const bf16*)(ws + WS_OG) + (size_t)row * 512 + 8 * lane;
    const u32x4 ra = *(const u32x4*)og, rb = *(const u32x4*)(og + (size_t)MALL * 512), rc = *(const u32x4*)(og + (size_t)2 * MALL * 512);
    const f32x4 a0 = (f32x4){bflo(ra.x), bfhi(ra.x), bflo(ra.y), bfhi(ra.y)}, a1 = (f32x4){bflo(ra.z), bfhi(ra.z), bflo(ra.w), bfhi(ra.w)};
    const f32x4 b0 = (f32x4){bflo(rb.x), bfhi(rb.x), bflo(rb.y), bfhi(rb.y)}, b1 = (f32x4){bflo(rb.z), bfhi(rb.z), bflo(rb.w), bfhi(rb.w)};
    const f32x4 c0 = (f32x4){bflo(rc.x), bfhi(rc.x), bflo(rc.y), bfhi(rc.y)}, c1 = (f32x4){bflo(rc.z), bfhi(rc.z), bflo(rc.w), bfhi(rc.w)};
    const f32x4 y0 = a0 * w0 + b0 * w1 + c0 * w2, y1 = a1 * w0 + b1 * w1 + c1 * w2;
    u32x4 w; w.x = cvt_pk_bf16(y0.x, y0.y); w.y = cvt_pk_bf16(y0.z, y0.w); w.z = cvt_pk_bf16(y1.x, y1.y); w.w = cvt_pk_bf16(y1.z, y1.w);
    *(u32x4*)((bf16*)(ws + WS_YCAT) + (size_t)row * KCAT + 1536 + 8 * lane) = w;
}

__device__ __forceinline__ float* x2_row(const Args& a, int row) { return row < MP ? a.out + OUT_YP + (size_t)row * DM : a.out + OUT_YS + (size_t)(row - MP) * DM; }
__device__ __forceinline__ void ins16(float (&v)[16], float x) {
#pragma unroll
    for (int k = 15; k >= 1; --k) v[k] = __builtin_amdgcn_fmed3f(x, v[k], v[k - 1]);
    v[0] = fmaxf(x, v[0]);
}
__device__ __forceinline__ float tag_key(float f, unsigned mask, unsigned idx) { return __uint_as_float((__float_as_uint(f) & ~mask) | idx); }
constexpr int TKR = 144;
__device__ __forceinline__ void topk_item(const Args& a, LAS unsigned char* L, int tid, int lane, int wave, int it) {
    unsigned char* ws = a.ws; tid = launder(tid); lane = launder(lane);
    const int tb = it >> 3, h = it & 7; const bool extra = tb < 2;
    const bf16* Q2 = (const bf16*)(ws + WS_QN); const bf16* SK = (const bf16*)(ws + WS_SUBK) + (size_t)h * 2 * 128 * 128;
    LAS unsigned char* QT = L; LAS unsigned char* KT = L + TKR * 528;
    LAS float* S = (LAS float*)L;
    LAS float* LV = (LAS float*)L; LAS int* LI = (LAS int*)(L + 2 * TKR * 16 * 4);
#pragma unroll
    for (int j = 0; j < 8; ++j) { const int task = j * 512 + tid, tt = task >> 5, c = task & 31; *(LAS u32x4*)(QT + tt * 528 + c * 16) = *(const u32x4*)(Q2 + (size_t)(tb * 128 + tt) * PQW + 256 * h + 8 * c); }
    { const int tt = 128 + (tid >> 5), c = tid & 31; *(LAS u32x4*)(QT + tt * 528 + c * 16) = *(const u32x4*)(Q2 + (size_t)(MP + (extra ? 16 * tb : 0) + (tid >> 5)) * PQW + 256 * h + 8 * c); }
#pragma unroll
    for (int j = 0; j < 8; ++j) { const int task = j * 512 + tid, rr = task >> 4, c = task & 15; *(LAS u32x4*)(KT + rr * 272 + c * 16) = *(const u32x4*)(SK + (size_t)rr * 128 + 8 * c); }
    __syncthreads();
    const int fr = lane & 15, fq = lane >> 4, p = wave >> 2;
    f32x4 acc[3][8];
#pragma unroll
    for (int mi = 0; mi < 3; ++mi) { const int mt = (mi < 2) ? 2 * (wave & 3) + mi : 8;
        if (mi == 2 && !(extra && (wave & 3) == 0)) break;
        bf16x8 qf[4];
#pragma unroll
        for (int ks = 0; ks < 4; ++ks) qf[ks] = *(const LAS bf16x8*)(QT + (16 * mt + fr) * 528 + (128 * p + 32 * ks + 8 * fq) * 2);
#pragma unroll
        for (int nt = 0; nt < 8; ++nt) { acc[mi][nt] = (f32x4){0.f, 0.f, 0.f, 0.f};
#pragma unroll
            for (int ks = 0; ks < 4; ++ks) { const bf16x8 kf = *(const LAS bf16x8*)(KT + (128 * p + 16 * nt + fr) * 272 + ks * 64 + fq * 16); acc[mi][nt] = __builtin_amdgcn_mfma_f32_16x16x32_bf16(kf, qf[ks], acc[mi][nt], 0, 0, 0); } } }
    __syncthreads();
#pragma unroll
    for (int mi = 0; mi < 3; ++mi) { const int tok = 16 * ((mi < 2) ? 2 * (wave & 3) + mi : 8) + fr;
        if (mi == 2 && !(extra && (wave & 3) == 0)) break;
#pragma unroll
        for (int nt = 0; nt < 8; ++nt)
#pragma unroll
            for (int e = 0; e < 4; ++e) S[(p * TKR + tok) * 129 + 16 * nt + 4 * fq + e] = acc[mi][nt][e]; }
    __syncthreads();
    float val[16]; int idx[16];
    const bool t1 = tid < 256 || (extra && tid < 288);
    const int sp = tid < 256 ? (tid >> 7) : ((tid - 256) >> 4), stok = tid < 256 ? (tid & 127) : 128 + ((tid - 256) & 15);
    if (t1) {
        const LAS float* sr = S + (sp * TKR + stok) * 129;
        float v[16];
#pragma unroll
        for (int k = 0; k < 16; ++k) v[k] = -3.0e38f;
#pragma unroll 4
        for (int key = 0; key < 128; ++key) ins16(v, tag_key(sr[key], 0x7Fu, (unsigned)key));
#pragma unroll
        for (int k = 0; k < 16; ++k) { idx[k] = (int)(__float_as_uint(v[k]) & 0x7Fu); val[k] = sr[idx[k]]; }
    }
    __syncthreads();
    if (t1) {
#pragma unroll
        for (int k = 0; k < 16; ++k) { LV[(sp * TKR + stok) * 16 + k] = val[k]; LI[(sp * TKR + stok) * 16 + k] = idx[k]; }
    }
    __syncthreads();
    if (tid < 128 || (extra && tid < TKR)) {
        float s1[16], s2[16];
#pragma unroll
        for (int k = 0; k < 16; ++k) { s1[k] = LV[tid * 16 + k]; s2[k] = LV[(TKR + tid) * 16 + k]; }
        float wf[16]; unsigned w[16];
#pragma unroll
        for (int k = 0; k < 16; ++k) wf[k] = -3.0e38f;
#pragma unroll
        for (int i = 0; i < 16; ++i)
#pragma unroll
            for (int j = 0; j < 16; ++j) if ((i + 1) * (j + 1) <= 16) ins16(wf, tag_key(s1[i] + s2[j], 0xFFu, (unsigned)(i * 16 + j)));
#pragma unroll
        for (int k = 0; k < 16; ++k) w[k] = __float_as_uint(wf[k]);
        float sv[16]; int id[16]; float mx = -3.0e38f;
#pragma unroll
        for (int k = 0; k < 16; ++k) { const int i = (w[k] >> 4) & 15, j = w[k] & 15; sv[k] = LV[tid * 16 + i] + LV[(TKR + tid) * 16 + j]; id[k] = LI[tid * 16 + i] * PNK + LI[(TKR + tid) * 16 + j]; mx = fmaxf(mx, sv[k]); }
        float den = 0.f;
#pragma unroll
        for (int k = 0; k < 16; ++k) { sv[k] = fast_exp(sv[k] - mx); den += sv[k]; }
        const float inv = 1.0f / den; const int row = tid < 128 ? tb * 128 + tid : MP + 16 * tb + (tid - 128);
        int* pid = (int*)(ws + WS_PID) + (size_t)row * 128 + 16 * h; float* pw = (float*)(ws + WS_PW) + (size_t)row * 128 + 16 * h;
#pragma unroll
        for (int k = 0; k < 16; k += 4) { *(int4*)(pid + k) = make_int4(id[k], id[k + 1], id[k + 2], id[k + 3]); *(f32x4*)(pw + k) = (f32x4){sv[k] * inv, sv[k + 1] * inv, sv[k + 2] * inv, sv[k + 3] * inv}; }
    }
    __syncthreads();
}
__device__ __forceinline__ void gather_row(const Args& a, int row, int lane) {
    unsigned char* ws = a.ws; lane = launder(lane);
    const bf16* U = (const bf16*)(ws + WS_U); const bf16* V = (const bf16*)(ws + WS_V);
    u32x4 hf[8];
    { const u32x4* hp = (const u32x4*)((const bf16*)(ws + WS_XN) + (size_t)row * DM) + lane;
#pragma unroll
      for (int j = 0; j < 8; ++j) hf[j] = hp[64 * j]; }
    const int* pid = (const int*)(ws + WS_PID) + (size_t)row * 128; const float* pw = (const float*)(ws + WS_PW) + (size_t)row * 128;
    const int id0 = pid[lane], id1 = pid[64 + lane]; const float w0 = pw[lane], w1 = pw[64 + lane];
    float o[8][8];
#pragma unroll
    for (int j = 0; j < 8; ++j)
#pragma unroll
        for (int e = 0; e < 8; ++e) o[j][e] = 0.f;
    for (int pr = 0; pr < 128; pr += 2) {
        int e0, e1; float g0, g1;
        if (pr < 64) { e0 = __builtin_amdgcn_readlane(id0, pr); e1 = __builtin_amdgcn_readlane(id0, pr + 1); g0 = __builtin_bit_cast(float, __builtin_amdgcn_readlane(__builtin_bit_cast(int, w0), pr)); g1 = __builtin_bit_cast(float, __builtin_amdgcn_readlane(__builtin_bit_cast(int, w0), pr + 1)); }
        else { e0 = __builtin_amdgcn_readlane(id1, pr - 64); e1 = __builtin_amdgcn_readlane(id1, pr - 63); g0 = __builtin_bit_cast(float, __builtin_amdgcn_readlane(__builtin_bit_cast(int, w1), pr - 64)); g1 = __builtin_bit_cast(float, __builtin_amdgcn_readlane(__builtin_bit_cast(int, w1), pr - 63)); }
        const u32x4* up0 = (const u32x4*)(U + (size_t)e0 * DM) + lane; const u32x4* up1 = (const u32x4*)(U + (size_t)e1 * DM) + lane;
        u32x4 ua[8], ub[8];
#pragma unroll
        for (int j = 0; j < 8; ++j) { ua[j] = up0[64 * j]; ub[j] = up1[64 * j]; }
        float d0 = 0.f, d1 = 0.f;
#pragma unroll
        for (int j = 0; j < 8; ++j) {
            const u32x4 hh = hf[j];
            d0 += bflo(hh.x) * bflo(ua[j].x) + bfhi(hh.x) * bfhi(ua[j].x) + bflo(hh.y) * bflo(ua[j].y) + bfhi(hh.y) * bfhi(ua[j].y) + bflo(hh.z) * bflo(ua[j].z) + bfhi(hh.z) * bfhi(ua[j].z) + bflo(hh.w) * bflo(ua[j].w) + bfhi(hh.w) * bfhi(ua[j].w);
            d1 += bflo(hh.x) * bflo(ub[j].x) + bfhi(hh.x) * bfhi(ub[j].x) + bflo(hh.y) * bflo(ub[j].y) + bfhi(hh.y) * bfhi(ub[j].y) + bflo(hh.z) * bflo(ub[j].z) + bfhi(hh.z) * bfhi(ub[j].z) + bflo(hh.w) * bflo(ub[j].w) + bfhi(hh.w) * bfhi(ub[j].w);
        }
#pragma unroll
        for (int s = 1; s < 64; s <<= 1) { d0 += __shfl_xor(d0, s); d1 += __shfl_xor(d1, s); }
        const float c0 = g0 * gelu_tanh(d0), c1 = g1 * gelu_tanh(d1);
        asm volatile("" ::: "memory");
        const u32x4* vp0 = (const u32x4*)(V + (size_t)e0 * DM) + lane; const u32x4* vp1 = (const u32x4*)(V + (size_t)e1 * DM) + lane;
#pragma unroll
        for (int j = 0; j < 8; ++j) { ua[j] = vp0[64 * j]; ub[j] = vp1[64 * j]; }
#pragma unroll
        for (int j = 0; j < 8; ++j) {
            o[j][0] += c0 * bflo(ua[j].x) + c1 * bflo(ub[j].x); o[j][1] += c0 * bfhi(ua[j].x) + c1 * bfhi(ub[j].x);
            o[j][2] += c0 * bflo(ua[j].y) + c1 * bflo(ub[j].y); o[j][3] += c0 * bfhi(ua[j].y) + c1 * bfhi(ub[j].y);
            o[j][4] += c0 * bflo(ua[j].z) + c1 * bflo(ub[j].z); o[j][5] += c0 * bfhi(ua[j].z) + c1 * bfhi(ub[j].z);
            o[j][6] += c0 * bflo(ua[j].w) + c1 * bflo(ub[j].w); o[j][7] += c0 * bfhi(ua[j].w) + c1 * bfhi(ub[j].w);
        }
    }
    float* y = x2_row(a, row) + 8 * lane;
#pragma unroll
    for (int j = 0; j < 8; ++j) { f32x4 p = *(f32x4*)(y + 512 * j), q = *(f32x4*)(y + 512 * j + 4);
        p.x += o[j][0]; p.y += o[j][1]; p.z += o[j][2]; p.w += o[j][3]; q.x += o[j][4]; q.y += o[j][5]; q.z += o[j][6]; q.w += o[j][7];
        *(f32x4*)(y + 512 * j) = p; *(f32x4*)(y + 512 * j + 4) = q; }
}


__device__ __forceinline__ float dot8_bf16(const u32x4 h, const u32x4 u, float acc) {
    typedef __bf16 bfx2 __attribute__((ext_vector_type(2)));
    const unsigned h0 = h.x, h1 = h.y, h2 = h.z, h3 = h.w, u0 = u.x, u1 = u.y, u2 = u.z, u3 = u.w;
    acc = __builtin_amdgcn_fdot2_f32_bf16(__builtin_bit_cast(bfx2, h0), __builtin_bit_cast(bfx2, u0), acc, false);
    acc = __builtin_amdgcn_fdot2_f32_bf16(__builtin_bit_cast(bfx2, h1), __builtin_bit_cast(bfx2, u1), acc, false);
    acc = __builtin_amdgcn_fdot2_f32_bf16(__builtin_bit_cast(bfx2, h2), __builtin_bit_cast(bfx2, u2), acc, false);
    acc = __builtin_amdgcn_fdot2_f32_bf16(__builtin_bit_cast(bfx2, h3), __builtin_bit_cast(bfx2, u3), acc, false);
    return acc;
}
__device__ __forceinline__ float rs8(const float (&av)[8], int lg) {
    const bool b0 = lg & 1, b1 = lg & 2, b2 = lg & 4;
    float k4[4];
#pragma unroll
    for (int k = 0; k < 4; ++k) { const float snd = b0 ? av[k] : av[4 + k], kp = b0 ? av[4 + k] : av[k]; k4[k] = kp + __shfl_xor(snd, 8); }
    float k2[2];
#pragma unroll
    for (int k = 0; k < 2; ++k) { const float snd = b1 ? k4[k] : k4[2 + k], kp = b1 ? k4[2 + k] : k4[k]; k2[k] = kp + __shfl_xor(snd, 16); }
    const float snd = b2 ? k2[0] : k2[1], kp = b2 ? k2[1] : k2[0];
    return kp + __shfl_xor(snd, 32);
}
__device__ __forceinline__ void peer_gather_phase(const Args& a, LAS unsigned char* L, int wave, int G) {
    unsigned char* ws = a.ws;
    LAS int* VO = (LAS int*)L;
    LAS float* CW = (LAS float*)(L + 16896);
    LAS float* OX = (LAS float*)(L + 33792);
    const char* U = (const char*)(ws + WS_U); const char* V = (const char*)(ws + WS_V); const char* HQ = (const char*)(ws + WS_H2Q);
    for (int grp = blockIdx.x; grp < MP / 32; grp += G) {
        const int lane = launder(lane_id()), tid = wave * 64 + lane, l8 = lane & 7, lg = lane >> 3;
        static_assert(MP / 32 == 8 * MS, "one 16-expert piece of a sample row per workgroup");
        const int row0 = grp * 32; const int xr = MP + (grp >> 3), pc = grp & 7;
        for (int i = tid; i < 33 * 128; i += 512) { const int tk = i >> 7; const int r = tk < 32 ? row0 + tk : xr; const int col = tk < 32 ? (i & 127) : 16 * pc + (i & 15);
            VO[i] = ((const int*)(ws + WS_PID))[(size_t)r * 128 + col] * 128; CW[i] = ((const float*)(ws + WS_PW))[(size_t)r * 128 + col]; }
        for (int i = tid; i < DM; i += 512) OX[i] = 0.f;
        __syncthreads();
        {
            int acc[66];
#pragma unroll
            for (int j = 0; j < 66; ++j) acc[j] = 0;
            const char* hb = HQ + (size_t)(row0 + 4 * wave) * DM + 16 * l8; const char* hx = HQ + (size_t)xr * DM + 16 * l8;
#ifndef GPROBE
#define GPROBE 0
#endif
            for (int gp_ = 0; gp_ < (GPROBE == 1 ? 2 : 1); ++gp_) {
            if (GPROBE == 1) {
#pragma unroll
                for (int j = 0; j < 66; ++j) acc[j] = 0; }
            for (int s = 0; s < 32; ++s) {
                const char* ub = U + (size_t)s * (PNE * 128); const unsigned lo = (unsigned)l8 * 16u;
                u32x4 bufA[8], bufB[8], bufC[8], hrT[3];
#define GU_ISSUE(buf, b) do { if ((b) < 8) { const int tk_ = (b) >> 1, hf_ = (b) & 1; if (hf_ == 0) hrT[tk_ % 3] = *(const u32x4*)(hb + (size_t)tk_ * DM + 128 * s); \
        _Pragma("unroll") for (int it = 0; it < 8; ++it) { const unsigned vo = (unsigned)VO[(4 * wave + tk_) * 128 + (8 * hf_ + it) * 8 + lg] + lo; buf[it] = *(const u32x4*)(ub + vo); } } \
    else { hrT[1] = *(const u32x4*)(hx + 128 * s); _Pragma("unroll") for (int x = 0; x < 2; ++x) { const unsigned vo = (unsigned)VO[32 * 128 + (2 * wave + x) * 8 + lg] + lo; buf[x] = *(const u32x4*)(ub + vo); } } \
    asm volatile("" ::: "memory"); } while (0)
#define GU_DOT(c, hr, u) do { c = __builtin_amdgcn_sdot4((int)hr.x, (int)u.x, c, false); c = __builtin_amdgcn_sdot4((int)hr.y, (int)u.y, c, false); c = __builtin_amdgcn_sdot4((int)hr.z, (int)u.z, c, false); c = __builtin_amdgcn_sdot4((int)hr.w, (int)u.w, c, false); } while (0)
#define GU_USE(buf, b) do { if ((b) < 8) { const int q_ = ((b) >> 1) * 16 + 8 * ((b) & 1); const u32x4 h_ = hrT[((b) >> 1) % 3]; _Pragma("unroll") for (int it = 0; it < 8; ++it) GU_DOT(acc[q_ + it], h_, buf[it]); \
        asm volatile("" : "+v"(acc[q_]), "+v"(acc[q_ + 1]), "+v"(acc[q_ + 2]), "+v"(acc[q_ + 3]), "+v"(acc[q_ + 4]), "+v"(acc[q_ + 5]), "+v"(acc[q_ + 6]), "+v"(acc[q_ + 7]) :: "memory"); } \
    else { const u32x4 h_ = hrT[1]; GU_DOT(acc[64], h_, buf[0]); GU_DOT(acc[65], h_, buf[1]); asm volatile("" : "+v"(acc[64]), "+v"(acc[65]) :: "memory"); } } while (0)
                GU_ISSUE(bufA, 0); GU_ISSUE(bufB, 1);
                GU_ISSUE(bufC, 2); GU_USE(bufA, 0);
                GU_ISSUE(bufA, 3); GU_USE(bufB, 1);
                GU_ISSUE(bufB, 4); GU_USE(bufC, 2);
                GU_ISSUE(bufC, 5); GU_USE(bufA, 3);
                GU_ISSUE(bufA, 6); GU_USE(bufB, 4);
                GU_ISSUE(bufB, 7); GU_USE(bufC, 5);
                if (wave == 0) { GU_ISSUE(bufC, 8); } GU_USE(bufA, 6);
                GU_USE(bufB, 7);
                if (wave == 0) { GU_USE(bufC, 8); }
#undef GU_ISSUE
#undef GU_USE
#undef GU_DOT
            }
            }
            const float* SU = (const float*)(ws + WS_SU); const float* SV = (const float*)(ws + WS_SV); const float* SH = (const float*)(ws + WS_SH);
#pragma unroll
            for (int j = 0; j < 66; ++j) {
                if (j >= 64 && wave != 0) continue;
                int di = acc[j]; di += __shfl_xor(di, 1); di += __shfl_xor(di, 2); di += __shfl_xor(di, 4);
                const int idx = (j < 64) ? (4 * wave + (j >> 4)) * 128 + (j & 15) * 8 + lg : 32 * 128 + (2 * wave + (j - 64)) * 8 + lg;
                const int e = VO[idx] >> 7; const int r = (j < 64) ? row0 + 4 * wave + (j >> 4) : xr;
                const float d = (float)di * SH[r] * SU[e];
                if (l8 == 0) CW[idx] = CW[idx] * gelu_tanh(d) * SV[e];
            }
        }
        LDS_WAIT();
        {
            const int jsel = 4 * (lg & 1) + 2 * ((lg >> 1) & 1) + ((lg >> 2) & 1);
            for (int gp_ = 0; gp_ < (GPROBE == 2 ? 2 : 1); ++gp_) {
            const bool st_ = (GPROBE != 2) || gp_ == 1;
            for (int s = 0; s < 32; ++s) {
                const char* vb = V + (size_t)s * (PNE * 128); const unsigned lo = (unsigned)l8 * 16u;
                u32x4 bufA[8], bufB[8]; float cfA[8], cfB[8]; float* ypT[2]; float yoT[2][2]; float av[16];
#define GV_ISSUE(buf, cf, b) do { if ((b) < 8) { const int tk_ = (b) >> 1, hf_ = (b) & 1; \
        if (hf_ == 0) { const int r_ = row0 + 4 * wave + tk_; ypT[tk_ & 1] = x2_row(a, r_) + 128 * s + 16 * l8 + jsel; const bf16* xb_ = (const bf16*)(ws + WS_XN) + (size_t)r_ * DM + 128 * s + 16 * l8 + jsel; yoT[tk_ & 1][0] = bf2f(xb_[0]); yoT[tk_ & 1][1] = bf2f(xb_[8]); } \
        _Pragma("unroll") for (int it = 0; it < 8; ++it) { const int idx = (4 * wave + tk_) * 128 + (8 * hf_ + it) * 8 + lg; const unsigned vo = (unsigned)VO[idx] + lo; cf[it] = CW[idx]; buf[it] = *(const u32x4*)(vb + vo); } } \
    else { _Pragma("unroll") for (int x = 0; x < 2; ++x) { const int idx = 32 * 128 + (2 * wave + x) * 8 + lg; const unsigned vo = (unsigned)VO[idx] + lo; cf[x] = CW[idx]; buf[x] = *(const u32x4*)(vb + vo); } } \
    asm volatile("" ::: "memory"); } while (0)
#define GV_FMA(C_, W_) do { const float c = (C_); const u32x4 wq_ = (W_); const unsigned w0 = wq_.x, w1 = wq_.y, w2 = wq_.z, w3 = wq_.w; f32x2 t; \
        t = __builtin_amdgcn_cvt_pk_f32_fp8((int)w0, false); av[0] += c * t.x; av[1] += c * t.y; t = __builtin_amdgcn_cvt_pk_f32_fp8((int)w0, true); av[2] += c * t.x; av[3] += c * t.y; \
        t = __builtin_amdgcn_cvt_pk_f32_fp8((int)w1, false); av[4] += c * t.x; av[5] += c * t.y; t = __builtin_amdgcn_cvt_pk_f32_fp8((int)w1, true); av[6] += c * t.x; av[7] += c * t.y; \
        t = __builtin_amdgcn_cvt_pk_f32_fp8((int)w2, false); av[8] += c * t.x; av[9] += c * t.y; t = __builtin_amdgcn_cvt_pk_f32_fp8((int)w2, true); av[10] += c * t.x; av[11] += c * t.y; \
        t = __builtin_amdgcn_cvt_pk_f32_fp8((int)w3, false); av[12] += c * t.x; av[13] += c * t.y; t = __builtin_amdgcn_cvt_pk_f32_fp8((int)w3, true); av[14] += c * t.x; av[15] += c * t.y; } while (0)
#define GV_PIN() do { asm volatile("" : "+v"(av[0]), "+v"(av[1]), "+v"(av[2]), "+v"(av[3]), "+v"(av[4]), "+v"(av[5]), "+v"(av[6]), "+v"(av[7]) :: "memory"); \
        asm volatile("" : "+v"(av[8]), "+v"(av[9]), "+v"(av[10]), "+v"(av[11]), "+v"(av[12]), "+v"(av[13]), "+v"(av[14]), "+v"(av[15]) :: "memory"); } while (0)
#define GV_USE(buf, cf, b) do { if ((b) < 8) { const int tk_ = (b) >> 1, hf_ = (b) & 1; if (hf_ == 0) { _Pragma("unroll") for (int e = 0; e < 16; ++e) av[e] = 0.f; } \
        _Pragma("unroll") for (int it = 0; it < 8; ++it) GV_FMA(cf[it], buf[it]); GV_PIN(); \
        if (hf_ == 1) { const float alo[8] = {av[0], av[1], av[2], av[3], av[4], av[5], av[6], av[7]}, ahi[8] = {av[8], av[9], av[10], av[11], av[12], av[13], av[14], av[15]}; \
            const float r0_ = yoT[tk_ & 1][0] + rs8(alo, lg), r1_ = yoT[tk_ & 1][1] + rs8(ahi, lg); if (st_) { ypT[tk_ & 1][0] = r0_; ypT[tk_ & 1][8] = r1_; } else if (r0_ == 1.2345e30f) ypT[tk_ & 1][0] = r1_; asm volatile("" ::: "memory"); } } \
    else { _Pragma("unroll") for (int e = 0; e < 16; ++e) av[e] = 0.f; GV_FMA(cf[0], buf[0]); GV_FMA(cf[1], buf[1]); \
        const float alo[8] = {av[0], av[1], av[2], av[3], av[4], av[5], av[6], av[7]}, ahi[8] = {av[8], av[9], av[10], av[11], av[12], av[13], av[14], av[15]}; const float r0 = rs8(alo, lg), r1 = rs8(ahi, lg); \
        if (st_) { __hip_atomic_fetch_add(OX + 128 * s + 16 * l8 + jsel, r0, __ATOMIC_RELAXED, __HIP_MEMORY_SCOPE_WORKGROUP); __hip_atomic_fetch_add(OX + 128 * s + 16 * l8 + 8 + jsel, r1, __ATOMIC_RELAXED, __HIP_MEMORY_SCOPE_WORKGROUP); } else if (r0 == 1.2345e30f) OX[0] = r1; } } while (0)
                GV_ISSUE(bufA, cfA, 0);
                GV_ISSUE(bufB, cfB, 1); GV_USE(bufA, cfA, 0);
                GV_ISSUE(bufA, cfA, 2); GV_USE(bufB, cfB, 1);
                GV_ISSUE(bufB, cfB, 3); GV_USE(bufA, cfA, 2);
                GV_ISSUE(bufA, cfA, 4); GV_USE(bufB, cfB, 3);
                GV_ISSUE(bufB, cfB, 5); GV_USE(bufA, cfA, 4);
                GV_ISSUE(bufA, cfA, 6); GV_USE(bufB, cfB, 5);
                GV_ISSUE(bufB, cfB, 7); GV_USE(bufA, cfA, 6);
                if (wave == 0) { GV_ISSUE(bufA, cfA, 8); } GV_USE(bufB, cfB, 7);
                if (wave == 0) { GV_USE(bufA, cfA, 8); }
#undef GV_ISSUE
#undef GV_FMA
#undef GV_PIN
#undef GV_USE
            }
            }
        }
        __syncthreads();
        { float* y = x2_row(a, xr); for (int i = tid; i < DM; i += 512) unsafeAtomicAdd(y + i, OX[i]); }
        __syncthreads();
    }
}

template <int NSEG, bool I8, class Epi> __device__ __forceinline__ void skinny16(const void* A_, int lda, const void* Bt_, int ldb, int n0, int nks, int ks1, int ks2, LAS float* red, int wave, Epi epi) {
    const int lane = launder(lane_id()), tid = wave * 64 + lane, fr = lane & 15, fq = lane >> 4;
    typedef int i32x4_t __attribute__((ext_vector_type(4)));
    f32x4 acc[NSEG][2]; i32x4_t iacc[NSEG][2];
#pragma unroll
    for (int sg = 0; sg < NSEG; ++sg) { acc[sg][0] = (f32x4){0.f, 0.f, 0.f, 0.f}; acc[sg][1] = (f32x4){0.f, 0.f, 0.f, 0.f}; iacc[sg][0] = (i32x4_t){0, 0, 0, 0}; iacc[sg][1] = (i32x4_t){0, 0, 0, 0}; }
    const char* bp = (const char*)Bt_ + (size_t)(n0 + fr) * ldb + 16 * fq; const char* ap0 = (const char*)A_ + (size_t)fr * lda + 16 * fq; const char* ap1 = (const char*)A_ + (size_t)(16 + fr) * lda + 16 * fq;
#pragma unroll 8
    for (int ks = wave; ks < nks; ks += 8) {
        const bf16x8 bf = *(const bf16x8*)(bp + 64 * ks), a0 = *(const bf16x8*)(ap0 + 64 * ks), a1 = *(const bf16x8*)(ap1 + 64 * ks);
        const int sg = (NSEG == 1) ? 0 : (ks < ks1 ? 0 : (ks < ks2 ? 1 : 2));
#pragma unroll
        for (int q = 0; q < NSEG; ++q) if (q == sg) {
            if (I8) { iacc[q][0] = __builtin_amdgcn_mfma_i32_16x16x64_i8(__builtin_bit_cast(i32x4_t, bf), __builtin_bit_cast(i32x4_t, a0), iacc[q][0], 0, 0, 0); iacc[q][1] = __builtin_amdgcn_mfma_i32_16x16x64_i8(__builtin_bit_cast(i32x4_t, bf), __builtin_bit_cast(i32x4_t, a1), iacc[q][1], 0, 0, 0); }
            else { acc[q][0] = __builtin_amdgcn_mfma_f32_16x16x32_bf16(bf, a0, acc[q][0], 0, 0, 0); acc[q][1] = __builtin_amdgcn_mfma_f32_16x16x32_bf16(bf, a1, acc[q][1], 0, 0, 0); }
        }
    }
#pragma unroll
    for (int sg = 0; sg < NSEG; ++sg)
#pragma unroll
        for (int mi = 0; mi < 2; ++mi)
#pragma unroll
            for (int r = 0; r < 4; ++r) red[((wave * NSEG + sg) * 2 + mi) * 256 + (4 * fq + r) * 16 + fr] = I8 ? (float)iacc[sg][mi][r] : acc[sg][mi][r];
    __syncthreads();
    {
        const int m = tid >> 4, n = tid & 15; float P[3] = {0.f, 0.f, 0.f};
#pragma unroll
        for (int sg = 0; sg < NSEG; ++sg)
#pragma unroll
            for (int w = 0; w < 8; ++w) P[sg] += red[((w * NSEG + sg) * 2 + (m >> 4)) * 256 + n * 16 + (m & 15)];
        epi(m, n0 + n, P[0], P[1], P[2]);
    }
    __syncthreads();
}

__device__ __forceinline__ void p1_skinny_i8_stream(const Args& a, LAS float* red, int wave, int q0, int qs) {
    typedef int i32x4_t __attribute__((ext_vector_type(4)));
    unsigned char* ws = a.ws;
    const int lane = launder(lane_id()), tid = wave * 64 + lane, fr = lane & 15, fq = lane >> 4;
    const char* A = (const char*)(ws + WS_XN8) + (size_t)MP * DM; const char* ap0 = A + (size_t)fr * DM + 16 * fq + 64 * wave; const char* ap1 = ap0 + (size_t)16 * DM;
    const float sa = ((const float*)(ws + WS_SA))[MP + (tid >> 4)];
    i32x4_t bf[8], a0[8], a1[8];
#define SKS_N0(q) (256 * (((q) >> 4) < 12 ? ((q) >> 4) + 6 : ((q) >> 4) + 18) + 16 * ((q) & 15))
#define SKS_LOAD(q) do { const char* bp = (const char*)(ws + WS_WIN8) + (size_t)(SKS_N0(q) + fr) * DM + 16 * fq + 64 * wave; \
        _Pragma("unroll") for (int j = 0; j < 8; ++j) { bf[j] = *(const i32x4_t*)(bp + 512 * j); a0[j] = *(const i32x4_t*)(ap0 + 512 * j); a1[j] = *(const i32x4_t*)(ap1 + 512 * j); } } while (0)
    if (q0 < 1024) SKS_LOAD(q0);
#pragma unroll 1
    for (int q = q0; q < 1024; q += qs) {
        const int n = SKS_N0(q) + (tid & 15), m = tid >> 4;
        const float scl = sa * ((const float*)(ws + WS_SW8))[n];
        i32x4_t c0 = (i32x4_t){0, 0, 0, 0}, c1 = (i32x4_t){0, 0, 0, 0};
#pragma unroll
        for (int j = 0; j < 8; ++j) { c0 = __builtin_amdgcn_mfma_i32_16x16x64_i8(bf[j], a0[j], c0, 0, 0, 0); c1 = __builtin_amdgcn_mfma_i32_16x16x64_i8(bf[j], a1[j], c1, 0, 0, 0); }
        asm volatile("" : "+v"(c0), "+v"(c1) :: "memory");
        const int qn = q + qs;
        if (qn < 1024) SKS_LOAD(qn);
        asm volatile("" ::: "memory");
#pragma unroll
        for (int r = 0; r < 4; ++r) { red[(wave * 2 + 0) * 256 + (4 * fq + r) * 16 + fr] = (float)c0[r]; red[(wave * 2 + 1) * 256 + (4 * fq + r) * 16 + fr] = (float)c1[r]; }
        __syncthreads();
        { float P = 0.f;
#pragma unroll
          for (int w = 0; w < 8; ++w) P += red[(w * 2 + (m >> 4)) * 256 + (tid & 15) * 16 + (m & 15)];
          const float v = P * scl;
          if (n >= O_GATE) (ws + WS_G8)[(size_t)(MP + m) * 12288 + (n - O_GATE)] = (unsigned char)((unsigned)(int)rintf(sigmoidf_(v) * 254.0f) + 1u);
          else ((bf16*)(ws + WS_Z))[(size_t)(MP + m) * INC + n] = (bf16)(cvt_pk_bf16(v, 0.f) & 0xffffu); }
        __syncthreads();
    }
#undef SKS_LOAD
#undef SKS_N0
}

constexpr int N_PHASES = 12;
__global__ void __launch_bounds__(512, 2) hawk_fwd(Args a) {
    extern __shared__ __attribute__((aligned(16))) unsigned char lds[];
    LAS unsigned char* L = (LAS unsigned char*)lds;
    const int wave = __builtin_amdgcn_readfirstlane((int)threadIdx.x >> 6), G = gridDim.x;
    volatile LAS unsigned* MISC = (volatile LAS unsigned*)(L + LDS_MISC);
    if (threadIdx.x < 64) MISC[threadIdx.x] = 0u;
#define lane lane_id()
#define tid (wave * 64 + lane_id())
    __syncthreads();
    unsigned char* ws = a.ws;
    const bool multi = (a.ph_hi - a.ph_lo) > 1;
    XcdBarrier bar; bar.bar = (unsigned*)(ws + WS_CTL) + CW_BAR + a.bar_region * XCD_BAR_WORDS; bar.x = 0; bar.st = MISC + 8;
    if (multi) bar = xcd_barrier_post((unsigned*)(ws + WS_CTL) + CW_BAR + a.bar_region * XCD_BAR_WORDS, MISC + 8);
    const int lo = a.ph_lo, hi = a.ph_hi;
#ifndef PHASE_MASK
#define PHASE_MASK 0xFFFF
#endif
#define IN(k) ((((PHASE_MASK) >> (k)) & 1) && lo <= (k) && (k) < hi)
#define SEAM(k) do { if (IN(k) && IN((k) + 1)) xcd_barrier(bar); } while (0)
#ifndef PROBE_DOUBLE
#define PROBE_DOUBLE 0
#endif
#define REP(k)
    const int gw = blockIdx.x * 8 + wave, NGW = G * 8;

    if (IN(0)) REP(0) { p0_prologue(a, L, tid, lane, wave, G); }
    if (IN(1)) REP(1) { p0b_prologue(a, L, tid, lane, wave, G); }
    SEAM(1);
    if (IN(2)) REP(2) {
        { pg8::Gemm g{(const bf16*)(ws + WS_XN8), (const bf16*)(ws + WS_WIN8), MP, INC, DM / 2}; pg8::SchedZ8 S; S.init(MP, 16384, G, (int)blockIdx.x);
          pg8::EpiQ8<true> E{(bf16*)(ws + WS_Z), INC, (const float*)(ws + WS_SA), (const float*)(ws + WS_SW8), ws + WS_G8}; pg8::gemm_phase<pg8::EpiQ8<true>, pg8::SchedZ8, true, true>(L, g, S, E); }
        const int sh = (G == 256) ? 96 : (2496 % G), cb = (int)((blockIdx.x + G - sh) % G);
        { pg8::Gemm g{(const bf16*)(ws + WS_XN), (const bf16*)(ws + WS_WINB), MP, 4608, DM}; pg8::SchedZB S; S.init(MP, 4608, G, cb);
          pg8::EpiZ E{(bf16*)(ws + WS_Z), INC}; pg8::gemm_phase<pg8::EpiZ, pg8::SchedZB, true, true>(L, g, S, E); }
        { pg8::Gemm g{(const bf16*)(ws + WS_MEMN), (const bf16*)(ws + WS_WMKV), 1024, 2048, DM}; pg8::StaticOrder S; S.init(1024, 2048, G, (int)((cb + G - (128 % G)) % G));
          pg8::EpiF32P E{(float*)(ws + WS_MKVRAW), 2048}; pg8::gemm_phase<pg8::EpiF32P, pg8::StaticOrder, true, true>(L, g, S, E); }
        {
            const int c0 = (int)blockIdx.x, cs = G, ce = 1312;
            for (int cg = c0; cg < ce; cg += cs) {
                if (cg < 288) skinny16<1, false>(ws + WS_XN + (size_t)MP * DM * 2, DM * 2, ws + WS_WINB, DM * 2, 16 * cg, DM / 32, 0, 0, (LAS float*)L, wave,
                    [&](int m, int n, float p0, float, float) { const int t = n >> 8, pno = t < 6 ? t : t + 12; ((bf16*)(ws + WS_Z))[(size_t)(MP + m) * INC + 256 * pno + (n & 255)] = (bf16)(cvt_pk_bf16(p0, 0.f) & 0xffffu); });
                else { p1_skinny_i8_stream(a, (LAS float*)L, wave, cg - 288, cs); break; }
            }
        }
    }
    SEAM(2);
    if (IN(3)) REP(3) { p2a_phase(a, L, tid, lane, wave, G); }
    SEAM(3);
    if (IN(4)) REP(4) { p2b_phase(a, L, tid, lane, wave, G); }
    SEAM(4);
    if (IN(5)) REP(5) { for (int m = gw; m < MREAL; m += NGW) combine_row(a, m, lane); }
    SEAM(5);
    if (IN(6)) REP(6) {
        auto sk = [&]() { for (int cg = blockIdx.x; cg < DM / 16; cg += G)
            skinny16<3, false>(ws + WS_YCAT + (size_t)MP * KCAT * 2, KCAT * 2, ws + WS_WCAT, KCAT * 2, 16 * cg, KCAT / 32, 48, 64, (LAS float*)L, wave,
                [&](int m, int n, float p0, float p1, float p2) { const unsigned char* zg = ws + WS_G8 + (size_t)(MP + m) * 12288 + n;
                    const float v = ((float)zg[0] * p0 + (float)zg[DM] * p1 + (float)zg[2 * DM] * p2) * (1.0f / 255.0f); ((bf16*)(ws + WS_MERGED))[(size_t)(MP + m) * DM + n] = (bf16)(cvt_pk_bf16(v, 0.f) & 0xffffu); }); };
        if (blockIdx.x & 1) sk();
        pg8::Gemm g{(const bf16*)(ws + WS_YCAT), (const bf16*)(ws + WS_WCAT), MP, DM, KCAT}; pg8::StaticOrder S; S.init(MP, DM, G, (int)blockIdx.x);
        pg8::EpiMerged E{24, 32, ws + WS_G8, 12288, (bf16*)(ws + WS_MERGED), DM}; pg8::gemm_phase<pg8::EpiMerged, pg8::StaticOrder, true, true>(L, g, S, E);
        if (!(blockIdx.x & 1)) sk();
    }
    SEAM(6);
    if (IN(7)) REP(7) {
        auto sk = [&]() { for (int cg = blockIdx.x; cg < DM / 16; cg += G)
            skinny16<1, false>(ws + WS_MERGED + (size_t)MP * DM * 2, DM * 2, ws + WS_WOUT, DM * 2, 16 * cg, DM / 32, 0, 0, (LAS float*)L, wave,
                [&](int m, int n, float p0, float, float) { ((bf16*)(ws + WS_XN))[(size_t)(MP + m) * DM + n] = (bf16)(cvt_pk_bf16(a.in[I_XS][(size_t)m * DM + n] + p0, 0.f) & 0xffffu); }); };
        if (blockIdx.x & 1) sk();
        pg8::Gemm g{(const bf16*)(ws + WS_MERGED), (const bf16*)(ws + WS_WOUT), MP, DM, DM}; pg8::StaticOrder S; S.init(MP, DM, G, (int)blockIdx.x);
        pg8::EpiOut E{a.in[I_XP], (bf16*)(ws + WS_XN), DM}; pg8::gemm_phase<pg8::EpiOut, pg8::StaticOrder, true, true>(L, g, S, E);
        if (!(blockIdx.x & 1)) sk();
    }
    SEAM(7);
    if (IN(8)) REP(8) {
        for (int m = gw; m < MREAL; m += NGW) rms_row_q8_from_bf16((const bf16*)(ws + WS_XN) + (size_t)m * DM, a.in[I_N2G], lane, (unsigned*)(ws + WS_H2Q) + (size_t)m * (DM / 4), (float*)(ws + WS_SH) + m);
        for (int m = MP + (NGW - 1 - gw); m < MREAL; m += NGW) {
            const u32x2* xr2 = (const u32x2*)((const bf16*)(ws + WS_XN) + (size_t)m * DM) + lane; f32x4* y4 = (f32x4*)x2_row(a, m) + lane;
#pragma unroll
            for (int j = 0; j < 16; ++j) { const u32x2 w = xr2[64 * j]; y4[64 * j] = (f32x4){bflo(w.x), bfhi(w.x), bflo(w.y), bfhi(w.y)}; }
        }
    }
    SEAM(8);
    if (IN(9)) REP(9) {
        pg8::Gemm g{(const bf16*)(ws + WS_H2Q), (const bf16*)(ws + WS_WQ8), MP, PQW, DM / 2}; pg8::StaticOrder S; S.init(MP, PQW, G, (int)blockIdx.x);
        pg8::EpiQ8<false> E{(bf16*)(ws + WS_QN), PQW, (const float*)(ws + WS_SH), (const float*)(ws + WS_SWQ), nullptr}; pg8::gemm_phase<pg8::EpiQ8<false>, pg8::StaticOrder, true, true>(L, g, S, E);
        for (int cg = blockIdx.x; cg < PQW / 16; cg += G)
            skinny16<1, true>(ws + WS_H2Q + (size_t)MP * DM, DM, ws + WS_WQ8, DM, 16 * cg, DM / 64, 0, 0, (LAS float*)L, wave,
                [&](int m, int n, float p0, float, float) { ((bf16*)(ws + WS_QN))[(size_t)(MP + m) * PQW + n] = (bf16)(cvt_pk_bf16(p0 * ((const float*)(ws + WS_SH))[MP + m] * ((const float*)(ws + WS_SWQ))[n], 0.f) & 0xffffu); });
    }
    SEAM(9);
    if (IN(10)) REP(10) { for (int it = blockIdx.x; it < 64 * 8; it += G) topk_item(a, L, tid, lane, wave, it); }
    SEAM(10);
    if (IN(11)) REP(11) { peer_gather_phase(a, L, wave, G); }
#undef IN
#undef SEAM
#undef lane
#undef tid
}

#ifndef MK_LAUNCH_PER_PHASE
#define MK_LAUNCH_PER_PHASE 0
#endif
extern "C" void kernel_launch(void* const* d_in, const int* in_sizes, int n_in, void* d_out, int out_size, void* d_ws, size_t ws_size, hipStream_t stream) {
    static int grid = 0;
    if (!grid) {
        if (n_in != N_IN || (size_t)out_size != OUT_END || ws_size < WS_END) { fprintf(stderr, "kernel_launch: unexpected shapes: n_in %d out %d ws %zu (need %zu)\n", n_in, out_size, ws_size, (size_t)WS_END); grid = -1; return; }
        int dev = 0, cus = 0, per_cu = 0;
        if (hipGetDevice(&dev) != hipSuccess || hipDeviceGetAttribute(&cus, hipDeviceAttributeMultiprocessorCount, dev) != hipSuccess) { grid = -1; return; }
        if (hipFuncSetAttribute((const void*)hawk_fwd, hipFuncAttributeMaxDynamicSharedMemorySize, LDS_BYTES) != hipSuccess) { fprintf(stderr, "kernel_launch: hipFuncSetAttribute failed\n"); grid = -1; return; }
        if (hipOccupancyMaxActiveBlocksPerMultiprocessor(&per_cu, (const void*)hawk_fwd, 512, LDS_BYTES) != hipSuccess || per_cu < 1) { fprintf(stderr, "kernel_launch: occupancy query says %d\n", per_cu); }
        grid = cus;
    }
    if (grid <= 0) return;
    if (hipMemsetAsync((char*)d_ws + WS_CTL, 0, CTL_BYTES, stream) != hipSuccess) return;
    Args a{};
    for (int i = 0; i < N_IN; ++i) a.in[i] = (const float*)d_in[i];
    a.out = (float*)d_out; a.ws = (unsigned char*)d_ws; a.pad = 0;
#if MK_LAUNCH_PER_PHASE
    for (int p = 0; p < N_PHASES; ++p) { a.ph_lo = p; a.ph_hi = p + 1; a.bar_region = 0; hipLaunchKernelGGL(hawk_fwd, dim3(grid), dim3(512), LDS_BYTES, stream, a); }
#elif defined(PROBE_PHASE)
    a.ph_lo = 0; a.ph_hi = PROBE_PHASE + 1; a.bar_region = 0; hipLaunchKernelGGL(hawk_fwd, dim3(grid), dim3(512), LDS_BYTES, stream, a);
    a.ph_lo = PROBE_PHASE; a.ph_hi = PROBE_PHASE + 1; a.bar_region = 1; hipLaunchKernelGGL(hawk_fwd, dim3(grid), dim3(512), LDS_BYTES, stream, a);
    if (PROBE_PHASE + 1 < N_PHASES) { a.ph_lo = PROBE_PHASE + 1; a.ph_hi = N_PHASES; a.bar_region = 2; hipLaunchKernelGGL(hawk_fwd, dim3(grid), dim3(512), LDS_BYTES, stream, a); }
#else
    a.ph_lo = 0; a.ph_hi = N_PHASES; a.bar_region = 0;
    hipLaunchKernelGGL(hawk_fwd, dim3(grid), dim3(512), LDS_BYTES, stream, a);
#endif
}
```
